# Optimizing an MI355X kernel written in HIP

```python
import math
import jax, jax.numpy as jnp
from jax import lax
import numpy as np

D_MODEL = 1024
BATCH = 8
SEQ = 4096
DEPTH = 2

RW_HEADS = 8
RW_HEAD_DIM = 64
RW_WIDTH = RW_HEADS * RW_HEAD_DIM
RW_DECAY_LORA = 64
RW_ICLR_LORA = 64
RW_GATE_LORA = 128
RW_COLS = 3 * RW_WIDTH + RW_DECAY_LORA + RW_ICLR_LORA + RW_GATE_LORA
RW_GN_EPS = 64e-5
DA_HEADS = 4
DA_HEAD_DIM = 64
DA_WIDTH = DA_HEADS * 2 * DA_HEAD_DIM
DA_COLS = 3 * DA_WIDTH
DA_BLOCK = 128
GD_HEADS = 4
GD_HEAD_DIM = 128
GD_WIDTH = GD_HEADS * GD_HEAD_DIM
GD_CONV = 4
GD_CHUNK = 64
GD_COLS = 3 * GD_WIDTH + 2 * GD_HEADS + GD_WIDTH
N_BRANCH = 3
BRANCH_WIDTH = 512
GATE_COLS = N_BRANCH * D_MODEL
IN_COLS = RW_COLS + DA_COLS + GD_COLS + GATE_COLS
D_FF = 2816
ALPHA = (2.0 * DEPTH) ** 0.25
BETA = (8.0 * DEPTH) ** -0.25

kernel_name = "hybrid_rwkv7_diffattn_gdn_macaron_deepnorm"

F32 = jnp.float32


def _layernorm(x, g, b, eps=1e-5):
    xf = x.astype(F32)
    mu = xf.mean(-1, keepdims=True)
    var = jnp.square(xf - mu).mean(-1, keepdims=True)
    return ((xf - mu) * lax.rsqrt(var + eps) * g + b).astype(x.dtype)


def _rmsnorm(x, g, eps):
    xf = x.astype(F32)
    return xf * lax.rsqrt(jnp.mean(jnp.square(xf), -1, keepdims=True) + eps) * g


def _l2norm(x, eps=1e-6):
    xf = x.astype(F32)
    return xf * lax.rsqrt(jnp.sum(jnp.square(xf), -1, keepdims=True) + eps)


def _swiglu(x, w_in, w_out):
    gate, up = jnp.split(x @ w_in, 2, axis=-1)
    return (jax.nn.silu(gate) * up) @ w_out


def _token_shift(z, mu):
    prev = jnp.pad(z, ((0, 0), (1, 0), (0, 0)))[:, :-1]
    return z + mu * (prev - z)


def _causal_dwconv(z, w):
    K = w.shape[0]
    L = z.shape[1]
    zp = jnp.pad(z, ((0, 0), (K - 1, 0), (0, 0)))
    out = zp[:, 0:L] * w[0]
    for j in range(1, K):
        out = out + zp[:, j:j + L] * w[j]
    return out


def _rwkv7(hr, mu, w0, w_up, a0, a_up, g_up, k_k, k_a, r_k, ln_g, ln_b):
    B, L, _ = hr.shape
    H, N, C = RW_HEADS, RW_HEAD_DIM, RW_WIDTH
    hr = _token_shift(hr, mu)
    r = hr[..., 0:C]
    k = hr[..., C:2 * C]
    v = hr[..., 2 * C:3 * C]
    wd = hr[..., 3 * C:3 * C + RW_DECAY_LORA]
    ad = hr[..., 3 * C + RW_DECAY_LORA:3 * C + RW_DECAY_LORA + RW_ICLR_LORA]
    gd = hr[..., 3 * C + RW_DECAY_LORA + RW_ICLR_LORA:]
    heads = lambda t: t.reshape(B, L, H, N)
    logw = -math.exp(-0.5) * jax.nn.sigmoid((w0 + jnp.tanh(wd) @ w_up).astype(F32))
    a = jax.nn.sigmoid((a0 + ad @ a_up).astype(F32))
    g = jax.nn.sigmoid(gd) @ g_up
    r, k, v = heads(r.astype(F32)), heads(k.astype(F32)), heads(v.astype(F32))
    a, w = heads(a), jnp.exp(heads(logw))
    kk = _l2norm(k * k_k.reshape(H, N).astype(F32))
    k = k * (1.0 + (a - 1.0) * k_a.reshape(H, N).astype(F32))

    def step(S, inp):
        r_t, w_t, k_t, v_t, kk_t, a_t = inp
        sk = jnp.einsum('bhvk,bhk->bhv', S, kk_t)
        S = (S * w_t[:, :, None, :] - sk[..., None] * (kk_t * a_t)[:, :, None, :]
             + v_t[..., None] * k_t[:, :, None, :])
        return S, jnp.einsum('bhvk,bhk->bhv', S, r_t)

    tm = lambda t: jnp.moveaxis(t, 1, 0)
    S0 = jnp.zeros((B, H, N, N), F32)
    _, y = lax.scan(step, S0, (tm(r), tm(w), tm(k), tm(v), tm(kk), tm(a)))
    y = jnp.moveaxis(y, 0, 1)
    ym = y.mean(-1, keepdims=True)
    yv = jnp.square(y - ym).mean(-1, keepdims=True)
    y = ((y - ym) * lax.rsqrt(yv + RW_GN_EPS)).reshape(B, L, C) * ln_g + ln_b
    bonus = jnp.sum(r * k * r_k.astype(F32), -1, keepdims=True) * v
    y = (y + bonus.reshape(B, L, C)) * g
    return y.astype(hr.dtype)


def _diff_attention(hd, lam_q1, lam_k1, lam_q2, lam_k2, norm_g, lam_init):
    B, L, _ = hd.shape
    H, d = DA_HEADS, DA_HEAD_DIM
    q = hd[..., 0:DA_WIDTH].astype(F32).reshape(B, L, H, 2, d).transpose(3, 0, 2, 1, 4)
    k = hd[..., DA_WIDTH:2 * DA_WIDTH].astype(F32).reshape(B, L, H, 2, d).transpose(3, 0, 2, 1, 4)
    v = hd[..., 2 * DA_WIDTH:].astype(F32).reshape(B, L, H, 2 * d).transpose(0, 2, 1, 3)
    lam = (jnp.exp(jnp.sum(lam_q1.astype(F32) * lam_k1.astype(F32)))
           - jnp.exp(jnp.sum(lam_q2.astype(F32) * lam_k2.astype(F32))) + lam_init)
    slopes = jnp.exp2(-8.0 * jnp.arange(1, H + 1, dtype=F32) / H)
    scale = d ** -0.5
    nb = L // DA_BLOCK
    qb = jnp.moveaxis(q.reshape(2, B, H, nb, DA_BLOCK, d), 3, 0)
    kpos = jnp.arange(L)

    def block(args):
        q_blk, i = args
        qpos = i * DA_BLOCK + jnp.arange(DA_BLOCK)
        dist = (qpos[:, None] - kpos[None, :]).astype(F32)
        bias = jnp.where(dist >= 0, -slopes[:, None, None] * dist, -jnp.inf)
        s = jnp.einsum('mbhqd,mbhkd->mbhqk', q_blk, k) * scale + bias
        p = jax.nn.softmax(s, axis=-1)
        p = p[0] - lam * p[1]
        return jnp.einsum('bhqk,bhkv->bhqv', p, v)

    o = lax.map(block, (qb, jnp.arange(nb)))
    o = jnp.moveaxis(o, 0, 2).reshape(B, H, L, 2 * d)
    o = _rmsnorm(o, norm_g, 1e-5) * (1.0 - lam_init)
    return o.transpose(0, 2, 1, 3).reshape(B, L, DA_WIDTH).astype(hd.dtype)


def _chunk_gated_delta(q, k, v, g, beta):
    B, H, L, dk = q.shape
    dv = v.shape[-1]
    C = GD_CHUNK
    n = L // C
    q = q.reshape(B, H, n, C, dk)
    k = k.reshape(B, H, n, C, dk)
    v = v.reshape(B, H, n, C, dv)
    g = g.reshape(B, H, n, C)
    beta = beta.reshape(B, H, n, C)
    G = jnp.cumsum(g, axis=-1)
    idx = jnp.arange(C)
    incl = idx[:, None] >= idx[None, :]
    strict = idx[:, None] > idx[None, :]
    decay = jnp.exp(jnp.where(incl, G[..., :, None] - G[..., None, :], -jnp.inf))
    kb = k * beta[..., None]
    Lm = jnp.where(strict, jnp.einsum('bhncd,bhnsd->bhncs', kb, k) * decay, 0.0)
    A = Lm + jnp.eye(C, dtype=Lm.dtype)
    U = lax.linalg.triangular_solve(A, v * beta[..., None], left_side=True, lower=True, unit_diagonal=True)
    W = lax.linalg.triangular_solve(A, kb * jnp.exp(G)[..., None], left_side=True, lower=True, unit_diagonal=True)
    intra = jnp.einsum('bhncd,bhnsd->bhncs', q, k) * decay
    G_last = G[..., -1:]
    qg = q * jnp.exp(G)[..., None]
    kd = k * jnp.exp(G_last - G)[..., None]
    gl = jnp.exp(G_last[..., 0])

    def step(S, inp):
        qg_c, kd_c, u_c, w_c, intra_c, gl_c = inp
        v_new = u_c - jnp.einsum('bhcd,bhdv->bhcv', w_c, S)
        o = jnp.einsum('bhcd,bhdv->bhcv', qg_c, S) + jnp.einsum('bhcs,bhsv->bhcv', intra_c, v_new)
        S = S * gl_c[..., None, None] + jnp.einsum('bhcd,bhcv->bhdv', kd_c, v_new)
        return S, o

    mv = lambda t: jnp.moveaxis(t, 2, 0)
    S0 = jnp.zeros((B, H, dk, dv), F32)
    _, o = lax.scan(step, S0, (mv(qg), mv(kd), mv(U), mv(W), mv(intra), mv(gl)))
    return jnp.moveaxis(o, 0, 2).reshape(B, H, L, dv)


def _gated_deltanet(hg, conv_w, a_log, dt_bias, norm_g):
    B, L, _ = hg.shape
    H, dh, Wd = GD_HEADS, GD_HEAD_DIM, GD_WIDTH
    qkv = jax.nn.silu(_causal_dwconv(hg[..., 0:3 * Wd], conv_w))
    a_lg = hg[..., 3 * Wd:3 * Wd + H].astype(F32)
    b_lg = hg[..., 3 * Wd + H:3 * Wd + 2 * H].astype(F32)
    z = hg[..., 3 * Wd + 2 * H:]
    heads = lambda t: t.reshape(B, L, H, dh).transpose(0, 2, 1, 3).astype(F32)
    q = _l2norm(heads(qkv[..., 0:Wd])) * (dh ** -0.5)
    k = _l2norm(heads(qkv[..., Wd:2 * Wd]))
    v = heads(qkv[..., 2 * Wd:])
    g = -(jnp.exp(a_log.astype(F32)) * jax.nn.softplus(a_lg + dt_bias.astype(F32))).transpose(0, 2, 1)
    beta = jax.nn.sigmoid(b_lg).transpose(0, 2, 1)
    o = _chunk_gated_delta(q, k, v, g, beta)
    o = _rmsnorm(o, norm_g, 1e-6) * jax.nn.silu(heads(z))
    return o.transpose(0, 2, 1, 3).reshape(B, L, Wd).astype(hg.dtype)


def _hybrid_mixer(x, layer, w_in, rw_shift_mu, rw_w0, rw_w_up, rw_a0, rw_a_up, rw_g_up, rw_k_k,
                  rw_k_a, rw_r_k, rw_ln_g, rw_ln_b, da_lam_q1, da_lam_k1, da_lam_q2, da_lam_k2,
                  da_norm_g, gd_conv_w, gd_a_log, gd_dt_bias, gd_norm_g, w_branch, w_out):
    B, L, _ = x.shape
    h = x @ w_in
    o1 = RW_COLS
    o2 = o1 + DA_COLS
    o3 = o2 + GD_COLS
    ya = _rwkv7(h[..., 0:o1], rw_shift_mu, rw_w0, rw_w_up, rw_a0, rw_a_up, rw_g_up,
                rw_k_k, rw_k_a, rw_r_k, rw_ln_g, rw_ln_b)
    lam_init = 0.8 - 0.6 * math.exp(-0.3 * layer)
    yb = _diff_attention(h[..., o1:o2], da_lam_q1, da_lam_k1, da_lam_q2, da_lam_k2, da_norm_g, lam_init)
    yc = _gated_deltanet(h[..., o2:o3], gd_conv_w, gd_a_log, gd_dt_bias, gd_norm_g)
    ys = jnp.stack([ya, yb, yc], axis=2)
    branches = jnp.einsum('blnc,ncd->blnd', ys, w_branch)
    gates = jax.nn.sigmoid(h[..., o3:].reshape(B, L, N_BRANCH, D_MODEL))
    merged = jnp.einsum('blnd,blnd->bld', gates, branches)
    return merged @ w_out


def setup_inputs(seed: int = 0) -> dict:
    key = jax.random.key(seed)
    ks = jax.random.split(key, 40)
    nrm = lambda i, shape, s: jax.random.normal(ks[i], shape, F32) * s
    gain = lambda i, shape: 1.0 + nrm(i, shape, 0.02)
    Dp, D = DEPTH, D_MODEL
    dt = jnp.exp(jax.random.uniform(ks[24], (Dp, GD_HEADS), F32, math.log(1e-3), math.log(1e-1)))
    return {
        "x": nrm(0, (BATCH, SEQ, D), 1.0),
        "ffn1_w_in": nrm(1, (Dp, D, 2 * D_FF), D ** -0.5),
        "ffn1_w_out": nrm(2, (Dp, D_FF, D), BETA * D_FF ** -0.5),
        "ln1_g": gain(3, (Dp, D)),
        "ln1_b": nrm(4, (Dp, D), 0.02),
        "mix_w_in": nrm(5, (Dp, D, IN_COLS), D ** -0.5),
        "rw_shift_mu": jax.random.uniform(ks[6], (Dp, RW_COLS), F32),
        "rw_w0": nrm(7, (Dp, RW_WIDTH), 0.5),
        "rw_w_up": nrm(8, (Dp, RW_DECAY_LORA, RW_WIDTH), 0.1),
        "rw_a0": nrm(9, (Dp, RW_WIDTH), 0.1),
        "rw_a_up": nrm(10, (Dp, RW_ICLR_LORA, RW_WIDTH), 0.1),
        "rw_g_up": nrm(11, (Dp, RW_GATE_LORA, RW_WIDTH), RW_GATE_LORA ** -0.5),
        "rw_k_k": 0.85 + nrm(12, (Dp, RW_WIDTH), 0.02),
        "rw_k_a": gain(13, (Dp, RW_WIDTH)),
        "rw_r_k": nrm(14, (Dp, RW_HEADS, RW_HEAD_DIM), 0.1),
        "rw_ln_g": gain(15, (Dp, RW_WIDTH)),
        "rw_ln_b": nrm(16, (Dp, RW_WIDTH), 0.02),
        "da_lam_q1": nrm(17, (Dp, DA_HEAD_DIM), 0.1),
        "da_lam_k1": nrm(18, (Dp, DA_HEAD_DIM), 0.1),
        "da_lam_q2": nrm(19, (Dp, DA_HEAD_DIM), 0.1),
        "da_lam_k2": nrm(20, (Dp, DA_HEAD_DIM), 0.1),
        "da_norm_g": gain(21, (Dp, 2 * DA_HEAD_DIM)),
        "gd_conv_w": nrm(22, (Dp, GD_CONV, 3 * GD_WIDTH), GD_CONV ** -0.5),
        "gd_a_log": jnp.log(jax.random.uniform(ks[23], (Dp, GD_HEADS), F32, 1.0, 16.0)),
        "gd_dt_bias": dt + jnp.log(-jnp.expm1(-dt)),
        "gd_norm_g": gain(25, (Dp, GD_HEAD_DIM)),
        "mix_w_branch": nrm(26, (Dp, N_BRANCH, BRANCH_WIDTH, D), BETA * BRANCH_WIDTH ** -0.5),
        "mix_w_out": nrm(27, (Dp, D, D), BETA * D ** -0.5),
        "ln2_g": gain(28, (Dp, D)),
        "ln2_b": nrm(29, (Dp, D), 0.02),
        "ffn2_w_in": nrm(30, (Dp, D, 2 * D_FF), D ** -0.5),
        "ffn2_w_out": nrm(31, (Dp, D_FF, D), BETA * D_FF ** -0.5),
        "ln3_g": gain(32, (Dp, D)),
        "ln3_b": nrm(33, (Dp, D), 0.02),
    }


def reference(x, ffn1_w_in, ffn1_w_out, ln1_g, ln1_b, mix_w_in, rw_shift_mu, rw_w0, rw_w_up,
              rw_a0, rw_a_up, rw_g_up, rw_k_k, rw_k_a, rw_r_k, rw_ln_g, rw_ln_b, da_lam_q1,
              da_lam_k1, da_lam_q2, da_lam_k2, da_norm_g, gd_conv_w, gd_a_log, gd_dt_bias,
              gd_norm_g, mix_w_branch, mix_w_out, ln2_g, ln2_b, ffn2_w_in, ffn2_w_out,
              ln3_g, ln3_b):
    for l in range(DEPTH):
        x = _layernorm(ALPHA * x + 0.5 * _swiglu(x, ffn1_w_in[l], ffn1_w_out[l]), ln1_g[l], ln1_b[l])
        mix = _hybrid_mixer(x, l, mix_w_in[l], rw_shift_mu[l], rw_w0[l], rw_w_up[l], rw_a0[l],
                            rw_a_up[l], rw_g_up[l], rw_k_k[l], rw_k_a[l], rw_r_k[l], rw_ln_g[l],
                            rw_ln_b[l], da_lam_q1[l], da_lam_k1[l], da_lam_q2[l], da_lam_k2[l],
                            da_norm_g[l], gd_conv_w[l], gd_a_log[l], gd_dt_bias[l], gd_norm_g[l],
                            mix_w_branch[l], mix_w_out[l])
        x = _layernorm(ALPHA * x + mix, ln2_g[l], ln2_b[l])
        x = _layernorm(ALPHA * x + 0.5 * _swiglu(x, ffn2_w_in[l], ffn2_w_out[l]), ln3_g[l], ln3_b[l])
    return x
```

```cpp
#include <hip/hip_runtime.h>
#include <hip/hip_cooperative_groups.h>
#include <cstdio>
#include <cstdint>
namespace cg = cooperative_groups;

#define LAS __attribute__((address_space(3)))
typedef unsigned short bf16;
typedef short bf16x8 __attribute__((ext_vector_type(8)));
typedef float f32x4 __attribute__((ext_vector_type(4)));
typedef float f32x2 __attribute__((ext_vector_type(2)));
typedef unsigned u32x4 __attribute__((ext_vector_type(4)));
typedef unsigned u32x2 __attribute__((ext_vector_type(2)));

#ifndef USE_CG_SYNC
#define USE_CG_SYNC 0
#endif
#ifndef DBG_DUMP
#define DBG_DUMP 0
#define DBG_SRC 0
#define DBG_N 0
#define DBG_HI (2 * PH_PER_LAYER)
#endif
#ifndef SKIP_RW
#define SKIP_RW 0
#endif
#ifndef SKIP_DA
#define SKIP_DA 0
#endif
#ifndef SKIP_GD
#define SKIP_GD 0
#endif
#ifndef SKIP_MIX
#define SKIP_MIX 0
#endif

constexpr int MTOK = 32768, MH = 16384, DM = 1024, DFF = 2816, SEQ = 4096;
constexpr int HMW = 5632;
constexpr int HGW = 3072;
constexpr int YW = 1536;
constexpr int NWAVES = 8;
constexpr int LDS_BYTES = 131072 + 1024;
constexpr float ALPHA = 1.41421356237f;

constexpr int C_RW = 0, C_DA = 1792, C_DAK = 2304, C_DAV = 2816, C_GD = 3328, C_GDA = 4864, C_GDB = 4868, C_GDZ = 4872;

constexpr size_t MiB = 1u << 20;
constexpr size_t WS_BON = 0;
constexpr size_t WS_GB = 1 * MiB;
constexpr size_t WS_BAR = 2 * MiB;
constexpr size_t WS_W = 4 * MiB;
constexpr size_t WS_XN = 60 * MiB;
constexpr size_t WS_A = 124 * MiB;
constexpr size_t WS_B = 300 * MiB;
constexpr size_t WS_P6 = WS_B, WS_GQK = WS_B + 96 * MiB, WS_GV = WS_B + 128 * MiB, WS_VT = WS_B + 144 * MiB;
constexpr size_t WS_C = 460 * MiB;
constexpr size_t WS_END = 508 * MiB;
constexpr size_t W_1 = 0, W_2 = 5767168, W_M = 8650752, W_G = 14417920, W_B = 17563648, W_O = 19136512, W_3 = 20185088, W_4 = 25952256;

__device__ __forceinline__ float bf2f(bf16 b) { return __uint_as_float((unsigned)b << 16); }
__device__ __forceinline__ float bflo(unsigned u) { return __uint_as_float(u << 16); }
__device__ __forceinline__ float bfhi(unsigned u) { return __uint_as_float(u & 0xffff0000u); }
typedef __bf16 bf16x2_t __attribute__((ext_vector_type(2)));
__device__ __forceinline__ unsigned pk2(float lo, float hi) { const f32x2 v = {lo, hi}; const bf16x2_t b = __builtin_convertvector(v, bf16x2_t); return __builtin_bit_cast(unsigned, b); }
__device__ __forceinline__ unsigned f2bf(float f) { return pk2(f, f) & 0xffffu; }
__device__ __forceinline__ float sigmoidf_(float x) { return __builtin_amdgcn_rcpf(1.0f + __expf(-x)); }
__device__ __forceinline__ float siluf_(float x) { return x * sigmoidf_(x); }
__device__ __forceinline__ float tanhf_(float x) { return 1.0f - 2.0f * __builtin_amdgcn_rcpf(__expf(2.0f * x) + 1.0f); }
template <int CTRL> __device__ __forceinline__ float dppf(float x) { return __int_as_float(__builtin_amdgcn_update_dpp(0, __float_as_int(x), CTRL, 0xf, 0xf, false)); }
__device__ __forceinline__ float row_sum16(float x) {
    x += dppf<0x128>(x); x += dppf<0x124>(x); x += dppf<0x122>(x); x += dppf<0x121>(x); return x;
}


#define XB_TMO      128
#define XB_XCNT(j)  (256  + 64 * (j))
#define XB_XSUB(j)  (1280 + 64 * (j))
#define XB_XGEN(j)  (2304 + 64 * (j))
#define XB_TOP      3328
#define XB_TOPGEN   3392
#define XCD_BAR_WORDS 3456
#define XB_SPIN_CAP (1u << 22)
__device__ __forceinline__ unsigned xb_ld(unsigned* p)              { return __hip_atomic_load(p, __ATOMIC_RELAXED, __HIP_MEMORY_SCOPE_AGENT); }
__device__ __forceinline__ unsigned xb_add(unsigned* p, unsigned v) { return __hip_atomic_fetch_add(p, v, __ATOMIC_RELAXED, __HIP_MEMORY_SCOPE_AGENT); }
__device__ __forceinline__ unsigned xb_xcc_id() { return (unsigned)__builtin_amdgcn_s_getreg((3 << 11) | 20) & 0xFu; }
#define XB_SPIN(cond, bar) do { unsigned _sp = 0; while (cond) { __builtin_amdgcn_s_sleep(1); \
    if ((++_sp & 255u) == 0u) { if (xb_ld(&(bar)[XB_TMO])) break; if (_sp > XB_SPIN_CAP) { atomicAdd(&(bar)[XB_TMO], 1u); break; } } } } while (0)
struct XcdBarrier { unsigned* bar; unsigned x; volatile LAS unsigned* st; };
__device__ __forceinline__ XcdBarrier xcd_barrier_post(unsigned* bar, volatile LAS unsigned* st) {
    XcdBarrier b; b.bar = bar; b.x = xb_xcc_id(); b.st = st;
    if (threadIdx.x == 0) (void)xb_add(&bar[XB_XCNT(b.x)], 1u);
    return b;
}
__device__ __forceinline__ void xcd_barrier_complete(unsigned* bar, unsigned x, unsigned& nloc, unsigned& nx) {
    const unsigned G = gridDim.x * gridDim.y * gridDim.z;
    unsigned sum, cnt, mine, sp = 0u;
    for (;;) {
        sum = 0u; cnt = 0u; mine = 0u;
#pragma unroll
        for (unsigned j = 0; j < 16; ++j) { const unsigned c = xb_ld(&bar[XB_XCNT(j)]); sum += c; cnt += (c > 0u) ? 1u : 0u; mine = (j == x) ? c : mine; }
        if (sum == G) break;
        __builtin_amdgcn_s_sleep(1);
        if ((++sp & 255u) == 0u) { if (xb_ld(&bar[XB_TMO])) break; if (sp > XB_SPIN_CAP) { atomicAdd(&bar[XB_TMO], 1u); break; } }
    }
    nloc = mine > 0u ? mine : 1u; nx = cnt > 0u ? cnt : 1u;
}
__device__ __forceinline__ void xcd_barrier(const XcdBarrier& b, const int wv) {
    asm volatile("s_waitcnt vmcnt(0)" ::: "memory");
    __syncthreads();
    if (wv == 0 && __builtin_amdgcn_mbcnt_hi(~0u, __builtin_amdgcn_mbcnt_lo(~0u, 0u)) == 0u) {
        unsigned* bar = b.bar;
        __builtin_amdgcn_s_waitcnt(0);
        unsigned nloc = b.st[0], nx = b.st[1];
        if (nloc == 0u) { xcd_barrier_complete(bar, b.x, nloc, nx); b.st[0] = nloc; b.st[1] = nx; }
        const unsigned old = xb_add(&bar[XB_XSUB(b.x)], 1u);
        const unsigned gen = old / nloc;
        if (old + 1u == (gen + 1u) * nloc) {
            __builtin_amdgcn_fence(__ATOMIC_RELEASE, "agent");
            asm volatile("s_waitcnt vmcnt(0)" ::: "memory");
            const unsigned og = xb_add(&bar[XB_TOP], 1u);
            const unsigned tg = og / nx;
            if (og + 1u == (tg + 1u) * nx) xb_add(&bar[XB_TOPGEN], 1u);
            else XB_SPIN(xb_ld(&bar[XB_TOPGEN]) == tg, bar);
            __builtin_amdgcn_fence(__ATOMIC_ACQUIRE, "agent");
            xb_add(&bar[XB_XGEN(b.x)], 1u);
            asm volatile("s_waitcnt vmcnt(0)" ::: "memory");
        } else {
            XB_SPIN(xb_ld(&bar[XB_XGEN(b.x)]) == gen, bar);
            __builtin_amdgcn_fence(__ATOMIC_ACQUIRE, "agent");
            asm volatile("s_waitcnt vmcnt(0)" ::: "memory");
        }
    }
    __syncthreads();
}

__device__ __forceinline__ void row_sum16x2(float& a, float& b) {
    a += dppf<0x128>(a); b += dppf<0x128>(b); a += dppf<0x124>(a); b += dppf<0x124>(b); a += dppf<0x122>(a); b += dppf<0x122>(b); a += dppf<0x121>(a); b += dppf<0x121>(b);
}
__device__ __forceinline__ float wave_sum(float v) {
    v = row_sum16(v);
    const int iv = __float_as_int(v);
    return (__int_as_float(__builtin_amdgcn_readlane(iv, 0)) + __int_as_float(__builtin_amdgcn_readlane(iv, 16))) + (__int_as_float(__builtin_amdgcn_readlane(iv, 32)) + __int_as_float(__builtin_amdgcn_readlane(iv, 48)));
}
namespace pg8 {
constexpr int BM = 256, BK = 64, HALF = 128, HTB = HALF * BK * 2, STAGE_BYTES = 8 * HTB, NXCD = 8, WGM = 8;
__host__ __device__ __forceinline__ int lds_byte(int r, int c) { const int st = (r >> 4) * 2 + (c >> 5), rr = r & 15, cc = c & 31, ob = rr * 64 + cc * 2; return st * 1024 + (ob ^ (((ob >> 9) & 1) << 5)); }
__host__ __device__ __forceinline__ void stage_rc(int b, int& R, int& C) { const int st = b / 1024, sb = b % 1024, swz = sb ^ (((sb >> 9) & 1) << 5); R = (st >> 1) * 16 + swz / 64; C = (st & 1) * 32 + (swz % 64) / 2; }
__host__ __device__ __forceinline__ int perm32(int rho) { const int n = rho >> 4, i = rho & 15; return 8 * (i >> 2) + 4 * n + (i & 3); }

struct Unit { int pm, pn, aofs, tag; };
struct Gemm { const bf16* A; const bf16* Bt; int lda, K; };

struct TileOrder {
    int nM, nN, nwg, G, c, nbr;
    __device__ void init(int M, int N, int G_, int c_, int nbr_) { nM = M / BM; nN = N / BM; nwg = nM * nN; G = G_; c = c_; nbr = nbr_; }
    __device__ bool next(int i, Unit& u) const {
        const int it = i / nbr, br = i - it * nbr;
        const long L = (long)it * G + c; if (L >= nwg) return false;
        int wgid = (int)L; { const int q = nwg / NXCD, r = nwg % NXCD, xcd = wgid % NXCD, off = wgid / NXCD; wgid = (xcd < r ? xcd * (q + 1) : r * (q + 1) + (xcd - r) * q) + off; }
        const int nig = WGM * nN, gid = wgid / nig, fm = gid * WGM, gsz = (nM - fm) < WGM ? (nM - fm) : WGM;
        u.pm = fm + ((wgid % nig) % gsz); u.pn = (wgid % nig) / gsz + br * nN; u.aofs = br * 1024; u.tag = br; return true;
    }
};

template <class Epi, int A_AUX = 0>
__device__ __forceinline__ void gemm_phase(LAS unsigned char* lds, const Gemm g, const TileOrder& S, const Epi& E, const int wid) {
    int lane = (int)__builtin_amdgcn_mbcnt_hi(~0u, __builtin_amdgcn_mbcnt_lo(~0u, 0u)); asm volatile("" : "+v"(lane));
    const int tid = wid * 64 + lane, wr = wid >> 2, wc = wid & 3, fr = lane & 15, fq = lane >> 4;
    const int K = g.K, nt = K / BK, lda = g.lda;
    unsigned voffA[2], voffB[2];
#pragma unroll
    for (int i = 0; i < 2; ++i) { int R, C; stage_rc(tid * 16 + i * 8192, R, C); const int Rb = Epi::PERM ? ((R & ~31) + perm32(R & 31)) : R;
        voffA[i] = (unsigned)(R * lda + C) * 2u; voffB[i] = (unsigned)(Rb * K + C) * 2u; }
    const size_t kstep = (size_t)(BK * 2);
    const size_t hstepA = (size_t)HALF * lda * 2, hstepB = (size_t)HALF * K * 2;
    const size_t tstepA = 2 * hstepA, tstepB = 2 * hstepB;
    const unsigned ldsw = (unsigned)wid * 1024u;
    const int aoff = lds_byte(wr * 64 + fr, fq * 8), boff = lds_byte(wc * 32 + fr, fq * 8);
#define PG8_SA(b, h) (((b) * 2 + (h)) * HTB)
#define PG8_SB(b, h) ((4 + (b) * 2 + (h)) * HTB)
#define PG8_STAGE_X(bufoff, gbase, voff, AUX) do { _Pragma("unroll") for (int _i = 0; _i < 2; ++_i) \
        __builtin_amdgcn_global_load_lds((const unsigned*)((const char*)(gbase) + (voff)[_i]), (LAS unsigned*)(lds + (bufoff) + ldsw + _i * 8192), 16, 0, AUX); } while (0)
#define PG8_STAGE(bufoff, gbase, voff) PG8_STAGE_X(bufoff, gbase, voff, 0)
#define PG8_STAGEA(bufoff, gbase, voff) PG8_STAGE_X(bufoff, gbase, voff, A_AUX)
#define PG8_LDA(dst, b, h) do { _Pragma("unroll") for (int m = 0; m < 4; ++m) _Pragma("unroll") for (int k = 0; k < 2; ++k) dst[m][k] = *(const LAS bf16x8*)(lds + PG8_SA(b, h) + aoff + m * 2048 + k * 1024); } while (0)
#define PG8_LDB(dst, b, h) do { _Pragma("unroll") for (int n = 0; n < 2; ++n) _Pragma("unroll") for (int k = 0; k < 2; ++k) dst[n][k] = *(const LAS bf16x8*)(lds + PG8_SB(b, h) + boff + n * 2048 + k * 1024); } while (0)
#define PG8_MMA(ai, bj, At, Bt) do { __builtin_amdgcn_s_setprio(1); _Pragma("unroll") for (int m = 0; m < 4; ++m) _Pragma("unroll") for (int n = 0; n < 2; ++n) _Pragma("unroll") for (int k = 0; k < 2; ++k) \
        acc[ai][bj][m][n] = __builtin_amdgcn_mfma_f32_16x16x32_bf16(Bt[n][k], At[m][k], acc[ai][bj][m][n], 0, 0, 0); __builtin_amdgcn_s_setprio(0); } while (0)
#define PG8_WAIT_V(n) asm volatile("s_waitcnt vmcnt(" #n ")" ::: "memory")
#define PG8_WAIT_L(n) asm volatile("s_waitcnt lgkmcnt(" #n ")" ::: "memory")
#define PG8_BAR __builtin_amdgcn_s_barrier()
#define PG8_SCHED __builtin_amdgcn_sched_barrier(0)
    Unit cur, nxt; int ui = 0;
    if (!S.next(0, cur)) return;
    f32x4 acc[2][2][4][2];
#pragma unroll
    for (int a = 0; a < 2; ++a)
#pragma unroll
        for (int b = 0; b < 2; ++b)
#pragma unroll
            for (int m = 0; m < 4; ++m)
#pragma unroll
                for (int n = 0; n < 2; ++n) acc[a][b][m][n] = (f32x4){0.f, 0.f, 0.f, 0.f};
    bf16x8 At[4][2], B0[2][2], B1[2][2];
    const char* cA = (const char*)g.A + (size_t)cur.pm * tstepA + cur.aofs; const char* cB = (const char*)g.Bt + (size_t)cur.pn * tstepB;
    {
        PG8_STAGE(PG8_SB(0, 0), cB, voffB); PG8_STAGE(PG8_SB(0, 1), cB + hstepB, voffB); PG8_STAGEA(PG8_SA(0, 0), cA, voffA); PG8_STAGEA(PG8_SA(0, 1), cA + hstepA, voffA);
        if (wr == 1) PG8_BAR;
        PG8_WAIT_V(2); PG8_BAR;
        PG8_STAGE(PG8_SB(1, 0), cB + kstep, voffB); PG8_STAGEA(PG8_SA(1, 0), cA + kstep, voffA); PG8_STAGE(PG8_SB(1, 1), cB + hstepB + kstep, voffB);
        PG8_WAIT_V(6); PG8_BAR;
    }
    for (;;) {
        const bool has_next = S.next(ui + 1, nxt);
        const char* nA = has_next ? (const char*)g.A + (size_t)nxt.pm * tstepA + nxt.aofs : cA; const char* nB = has_next ? (const char*)g.Bt + (size_t)nxt.pn * tstepB : cB;
        for (int t = 0; t < nt; t += 2) {
            const bool last = (t == nt - 2);
            const char* a1 = cA + (size_t)(t + 1) * kstep;
            const char* a2 = last ? nA : cA + (size_t)(t + 2) * kstep; const char* b2 = last ? nB : cB + (size_t)(t + 2) * kstep;
            const char* a3 = a2 + kstep; const char* b3 = b2 + kstep;
            PG8_LDB(B0, 0, 0); PG8_LDB(B1, 0, 1); PG8_SCHED; PG8_LDA(At, 0, 0); PG8_STAGEA(PG8_SA(1, 1), a1 + hstepA, voffA);
            PG8_WAIT_V(8); PG8_WAIT_L(0); PG8_BAR; PG8_MMA(0, 0, At, B0); PG8_MMA(0, 1, At, B1); PG8_BAR; PG8_SCHED;
            PG8_LDA(At, 0, 1); PG8_STAGE(PG8_SB(0, 0), b2, voffB); PG8_STAGE(PG8_SB(0, 1), b2 + hstepB, voffB); PG8_STAGEA(PG8_SA(0, 0), a2, voffA);
            PG8_WAIT_V(8); PG8_WAIT_L(0); PG8_BAR; PG8_MMA(1, 0, At, B0); PG8_MMA(1, 1, At, B1); PG8_BAR; PG8_SCHED;
            PG8_LDB(B0, 1, 0); PG8_LDB(B1, 1, 1); PG8_SCHED; PG8_LDA(At, 1, 0); PG8_STAGEA(PG8_SA(0, 1), a2 + hstepA, voffA);
            PG8_WAIT_V(8); PG8_WAIT_L(0); PG8_BAR; PG8_MMA(0, 0, At, B0); PG8_MMA(0, 1, At, B1); PG8_BAR; PG8_SCHED;
            PG8_LDA(At, 1, 1); PG8_STAGE(PG8_SB(1, 0), b3, voffB); PG8_STAGE(PG8_SB(1, 1), b3 + hstepB, voffB); PG8_STAGEA(PG8_SA(1, 0), a3, voffA);
            PG8_WAIT_V(8); PG8_WAIT_L(0); PG8_BAR; PG8_MMA(1, 0, At, B0); PG8_MMA(1, 1, At, B1); PG8_BAR; PG8_SCHED;
        }
        if (wr == 0) PG8_BAR;
        E(acc, cur, wr, wc, fr, fq);
        if (!has_next) break;
#pragma unroll
        for (int a = 0; a < 2; ++a)
#pragma unroll
            for (int b = 0; b < 2; ++b)
#pragma unroll
                for (int m = 0; m < 4; ++m)
#pragma unroll
                    for (int n = 0; n < 2; ++n) acc[a][b][m][n] = (f32x4){0.f, 0.f, 0.f, 0.f};
        cur = nxt; cA = nA; cB = nB; ++ui;
        if (wr == 1) PG8_BAR;
    }
    PG8_WAIT_V(0);
    PG8_BAR;
#undef PG8_SA
#undef PG8_SB
#undef PG8_STAGE
#undef PG8_STAGEA
#undef PG8_STAGE_X
#undef PG8_LDA
#undef PG8_LDB
#undef PG8_MMA
#undef PG8_WAIT_V
#undef PG8_WAIT_L
#undef PG8_BAR
#undef PG8_SCHED
}

typedef f32x4 Acc[2][2][4][2];

struct EpiSwiglu {
    static constexpr bool PERM = true; bf16* O;
    __device__ __forceinline__ void operator()(const Acc& acc, const Unit& u, int wr, int wc, int fr, int fq) const {
        const int row0 = u.pm * BM + wr * 64 + fr, col0 = u.pn * 128 + wc * 32 + 8 * fq;
#pragma unroll
        for (int ai = 0; ai < 2; ++ai)
#pragma unroll
            for (int m = 0; m < 4; ++m) {
                bf16* rowp = O + (size_t)(row0 + ai * HALF + m * 16) * DFF + col0;
                const f32x4 g0 = acc[ai][0][m][0], g1 = acc[ai][0][m][1], u0 = acc[ai][1][m][0], u1 = acc[ai][1][m][1];
                u32x4 w;
                w.x = pk2(siluf_(g0[0]) * u0[0], siluf_(g0[1]) * u0[1]); w.y = pk2(siluf_(g0[2]) * u0[2], siluf_(g0[3]) * u0[3]);
                w.z = pk2(siluf_(g1[0]) * u1[0], siluf_(g1[1]) * u1[1]); w.w = pk2(siluf_(g1[2]) * u1[2], siluf_(g1[3]) * u1[3]);
                *(u32x4*)rowp = w;
            }
    }
};
struct EpiResid {
    static constexpr bool PERM = false; const float* base; float* out; float alpha, s;
    __device__ __forceinline__ void operator()(const Acc& acc, const Unit& u, int wr, int wc, int fr, int fq) const {
        const int col0 = u.pn * BM + wc * 32 + 4 * fq;
#pragma unroll
        for (int ai = 0; ai < 2; ++ai)
#pragma unroll
            for (int m = 0; m < 4; ++m) {
                const size_t off = (size_t)(u.pm * BM + ai * HALF + wr * 64 + m * 16 + fr) * DM + col0;
#pragma unroll
                for (int bj = 0; bj < 2; ++bj)
#pragma unroll
                    for (int n = 0; n < 2; ++n) { const f32x4 b = *(const f32x4*)(base + off + bj * HALF + n * 16); *(f32x4*)(out + off + bj * HALF + n * 16) = b * alpha + acc[ai][bj][m][n] * s; }
            }
    }
};
struct EpiHm {
    static constexpr bool PERM = true; bf16* O; bf16* Vt; int ldc, vlo;
    __device__ __forceinline__ void operator()(const Acc& acc, const Unit& u, int wr, int wc, int fr, int fq) const {
        const int row0 = u.pm * BM + wr * 64 + fr;
        if (u.pn == vlo || u.pn == vlo + 1) {
#pragma unroll
            for (int ai = 0; ai < 2; ++ai)
#pragma unroll
                for (int m = 0; m < 4; ++m) {
                    const int r = row0 + ai * HALF + m * 16, bl = r >> 12, t = r & 4095;
#pragma unroll
                    for (int bj = 0; bj < 2; ++bj)
#pragma unroll
                        for (int n = 0; n < 2; ++n)
#pragma unroll
                            for (int e = 0; e < 4; ++e) {
                                const int cv = (u.pn - vlo) * 256 + bj * HALF + wc * 32 + 8 * fq + 4 * n + e;
                                Vt[((size_t)(bl * 4 + (cv >> 7)) * 128 + (cv & 127)) * SEQ + t] = (bf16)f2bf(acc[ai][bj][m][n][e]);
                            }
                }
            return;
        }
        const int col0 = u.pn * BM + wc * 32 + 8 * fq;
#pragma unroll
        for (int ai = 0; ai < 2; ++ai)
#pragma unroll
            for (int m = 0; m < 4; ++m) {
                bf16* rowp = O + (size_t)(row0 + ai * HALF + m * 16) * ldc + col0;
#pragma unroll
                for (int bj = 0; bj < 2; ++bj) { const f32x4 v0 = acc[ai][bj][m][0], v1 = acc[ai][bj][m][1]; u32x4 w; w.x = pk2(v0[0], v0[1]); w.y = pk2(v0[2], v0[3]); w.z = pk2(v1[0], v1[1]); w.w = pk2(v1[2], v1[3]); *(u32x4*)(rowp + bj * HALF) = w; }
            }
    }
};
struct EpiMerge {
    static constexpr bool PERM = true; const bf16* Hg; bf16* Mg;
    __device__ __forceinline__ void operator()(const Acc& acc, const Unit& u, int wr, int wc, int fr, int fq) const {
        const int br = u.tag, pn4 = u.pn - 4 * br;
        const int row0 = u.pm * BM + wr * 64 + fr, col0 = pn4 * BM + wc * 32 + 8 * fq;
#pragma unroll
        for (int ai = 0; ai < 2; ++ai)
#pragma unroll
            for (int m = 0; m < 4; ++m) {
                const int r = row0 + ai * HALF + m * 16;
#pragma unroll
                for (int bj = 0; bj < 2; ++bj) {
                    const unsigned long long* gq = (const unsigned long long*)(Hg + (size_t)r * HGW + br * 1024 + col0 + bj * HALF);
                    const unsigned long long g0 = __hip_atomic_load(gq, __ATOMIC_RELAXED, __HIP_MEMORY_SCOPE_AGENT), g1 = __hip_atomic_load(gq + 1, __ATOMIC_RELAXED, __HIP_MEMORY_SCOPE_AGENT);
                    u32x4 gt; gt.x = (unsigned)g0; gt.y = (unsigned)(g0 >> 32); gt.z = (unsigned)g1; gt.w = (unsigned)(g1 >> 32);
                    bf16* mp = Mg + (size_t)r * DM + col0 + bj * HALF;
                    const f32x4 v0 = acc[ai][bj][m][0], v1 = acc[ai][bj][m][1];
                    float o[8] = {sigmoidf_(bflo(gt.x)) * v0[0], sigmoidf_(bfhi(gt.x)) * v0[1], sigmoidf_(bflo(gt.y)) * v0[2], sigmoidf_(bfhi(gt.y)) * v0[3], sigmoidf_(bflo(gt.z)) * v1[0], sigmoidf_(bfhi(gt.z)) * v1[1], sigmoidf_(bflo(gt.w)) * v1[2], sigmoidf_(bfhi(gt.w)) * v1[3]};
                    if (br > 0) {
                        const unsigned long long q0 = __hip_atomic_load((const unsigned long long*)mp, __ATOMIC_RELAXED, __HIP_MEMORY_SCOPE_AGENT), q1 = __hip_atomic_load((const unsigned long long*)mp + 1, __ATOMIC_RELAXED, __HIP_MEMORY_SCOPE_AGENT);
                        u32x4 od; od.x = (unsigned)q0; od.y = (unsigned)(q0 >> 32); od.z = (unsigned)q1; od.w = (unsigned)(q1 >> 32); o[0] += bflo(od.x); o[1] += bfhi(od.x); o[2] += bflo(od.y); o[3] += bfhi(od.y); o[4] += bflo(od.z); o[5] += bfhi(od.z); o[6] += bflo(od.w); o[7] += bfhi(od.w); }
                    u32x4 w; w.x = pk2(o[0], o[1]); w.y = pk2(o[2], o[3]); w.z = pk2(o[4], o[5]); w.w = pk2(o[6], o[7]); *(u32x4*)mp = w;
                }
            }
    }
};
}

struct Params { const float* in[34]; float* out; unsigned char* ws; int ph_lo, ph_hi; };

struct Ctx {
    LAS unsigned char* lds; int G, bid, wv;
    float* X; unsigned char* ws;
};
#define c_W   ((bf16*)(c.ws + WS_W))
#define c_XN  ((bf16*)(c.ws + WS_XN))
#define c_HB  ((bf16*)(c.ws + WS_A))
#define c_Hm  ((bf16*)(c.ws + WS_A))
#define c_Mg  ((bf16*)(c.ws + WS_A))
#define c_P6  ((bf16*)(c.ws + WS_P6))
#define c_GQK ((bf16*)(c.ws + WS_GQK))
#define c_GV  ((bf16*)(c.ws + WS_GV))
#define c_Vt  ((bf16*)(c.ws + WS_VT))
#define c_Hg  ((bf16*)(c.ws + WS_P6))
#define c_Y   ((bf16*)(c.ws + WS_C))
#define c_BON ((float*)(c.ws + WS_BON))
#define c_GB  ((float*)(c.ws + WS_GB))
__device__ __forceinline__ const float* in_ptr(int i) {
    const char __attribute__((address_space(4)))* ka = (const char __attribute__((address_space(4)))*)__builtin_amdgcn_kernarg_segment_ptr();
    asm volatile("" : "+s"(ka));
    return *(const float* const __attribute__((address_space(4)))*)(ka + 8 * i);
}
#define PHASE_IDS() const int wave = c.wv; int lane = (int)__builtin_amdgcn_mbcnt_hi(~0u, __builtin_amdgcn_mbcnt_lo(~0u, 0u)); asm volatile("" : "+v"(lane)); const int tid = wave * 64 + lane; (void)tid

template <int MODE> __device__ __forceinline__ int wrow_map(int j) {
    if (MODE == 1) { const int up = j >= DFF, i = up ? j - DFF : j; return (i >> 7) * 256 + up * 128 + (i & 127); }
    if (MODE == 2) return j < 5384 ? j : 5632 + (j - 5384);
    return j;
}
template <int MODE> __device__ __forceinline__ void transpose_item(const float* W, int K, int N, bf16* WT, int row_off, LAS float* scr, int item, int lane) {
    const int nblk = (N + 31) / 32, kb = item / nblk, nb = item % nblk, k0 = 64 * kb, n0 = 32 * nb;
    const int colr = n0 + (lane & 31);
    float tv[32];
#pragma unroll
    for (int i = 0; i < 32; ++i) { const int kk = 2 * i + (lane >> 5); tv[i] = colr < N ? W[(size_t)(k0 + kk) * N + colr] : 0.f; }
#pragma unroll
    for (int i = 0; i < 32; ++i) { const int kk = 2 * i + (lane >> 5); scr[kk * 33 + (lane & 31)] = tv[i]; }
    asm volatile("s_waitcnt lgkmcnt(0)" ::: "memory");
    const int c = lane & 7;
#pragma unroll
    for (int j = 0; j < 4; ++j) { const int n = (lane >> 3) + 8 * j; const LAS float* s = scr + (8 * c) * 33 + n;
        u32x4 o; o.x = pk2(s[0 * 33], s[1 * 33]); o.y = pk2(s[2 * 33], s[3 * 33]); o.z = pk2(s[4 * 33], s[5 * 33]); o.w = pk2(s[6 * 33], s[7 * 33]);
        if (n0 + n < N) *(u32x4*)(WT + (size_t)(row_off + wrow_map<MODE>(n0 + n)) * K + k0 + 8 * c) = o; }
    asm volatile("s_waitcnt lgkmcnt(0)" ::: "memory");
}
constexpr int WI1 = 16 * 176, WI2 = 44 * 32, WNIT = 2 * (WI1 + WI2) + 16 * 265 + 3 * 8 * 32 + 16 * 32;
__device__ __forceinline__ void ph_weights(const Ctx& c, int l, const int it_lo, const int it_hi, const int wv0, const int wvn) {
    PHASE_IDS();
    LAS float* scr = (LAS float*)(c.lds + wave * 16384);
    if (wave < wv0 || wave >= wv0 + wvn) return;
    const int gw = c.bid * wvn + (wave - wv0), NGW = c.G * wvn;
    constexpr int I1 = 16 * 176, I2 = 44 * 32, I3 = 16 * 265, I4 = 8 * 32, I5 = 16 * 32;
    constexpr int NIT = I1 + I2 + I3 + 3 * I4 + I5 + I1 + I2;
    const float* w1 = in_ptr(1) + (size_t)l * DM * 2 * DFF; const float* w2 = in_ptr(2) + (size_t)l * DFF * DM;
    const float* wm = in_ptr(5) + (size_t)l * DM * 8456; const float* wb = in_ptr(26) + (size_t)l * 3 * 512 * DM; const float* wo = in_ptr(27) + (size_t)l * DM * DM;
    const float* w3 = in_ptr(30) + (size_t)l * DM * 2 * DFF; const float* w4 = in_ptr(31) + (size_t)l * DFF * DM;
    for (int it = it_lo + gw; it < it_hi; it += NGW) {
        int r = it;
        if (r < I1) { transpose_item<1>(w1, DM, 2 * DFF, c_W + W_1, 0, scr, r, lane); continue; } r -= I1;
        if (r < I2) { transpose_item<0>(w2, DFF, DM, c_W + W_2, 0, scr, r, lane); continue; } r -= I2;
        if (r < I3) { transpose_item<2>(wm, DM, 8456, c_W + W_M, 0, scr, r, lane); continue; } r -= I3;
        if (r < 3 * I4) { const int br = r / I4; transpose_item<0>(wb + (size_t)br * 512 * DM, 512, DM, c_W + W_B, br * 1024, scr, r - br * I4, lane); continue; } r -= 3 * I4;
        if (r < I5) { transpose_item<0>(wo, DM, DM, c_W + W_O, 0, scr, r, lane); continue; } r -= I5;
        if (r < I1) { transpose_item<1>(w3, DM, 2 * DFF, c_W + W_3, 0, scr, r, lane); continue; } r -= I1;
        transpose_item<0>(w4, DFF, DM, c_W + W_4, 0, scr, r, lane);
    }
}

__device__ __forceinline__ void ph_ln(const Ctx& c, const float* g, const float* b, const int wc) {
    PHASE_IDS();
    if (wave >= wc) return;
    const int gw = c.bid * wc + wave, NGW = c.G * wc;
    f32x4 gv[4], bv[4];
#pragma unroll
    for (int j = 0; j < 4; ++j) { gv[j] = *((const f32x4*)g + lane + 64 * j); bv[j] = *((const f32x4*)b + lane + 64 * j); }
    for (int m0 = gw; m0 < MTOK; m0 += 8 * NGW) {
        f32x4 v[8][4];
#pragma unroll
        for (int r = 0; r < 8; ++r) { const int mr = (m0 + r * NGW) < MTOK ? (m0 + r * NGW) : m0; const f32x4* xr = (const f32x4*)(c.X + (size_t)mr * DM) + lane;
#pragma unroll
            for (int j = 0; j < 4; ++j) v[r][j] = xr[64 * j]; }
#pragma unroll
        for (int r = 0; r < 8; ++r) {
            const int m = m0 + r * NGW; if (m >= MTOK) break;
            f32x4* xr = (f32x4*)(c.X + (size_t)m * DM) + lane;
            float s = 0.f;
#pragma unroll
            for (int j = 0; j < 4; ++j) s += (v[r][j].x + v[r][j].y) + (v[r][j].z + v[r][j].w);
            const float mean = wave_sum(s) * (1.f / DM); float s2 = 0.f;
#pragma unroll
            for (int j = 0; j < 4; ++j) { v[r][j] = v[r][j] - mean; s2 += (v[r][j].x * v[r][j].x + v[r][j].y * v[r][j].y) + (v[r][j].z * v[r][j].z + v[r][j].w * v[r][j].w); }
            const float rstd = __builtin_amdgcn_rsqf(wave_sum(s2) * (1.f / DM) + 1e-5f);
            u32x2* o8 = (u32x2*)(c_XN + (size_t)m * DM) + lane;
#pragma unroll
            for (int j = 0; j < 4; ++j) { const f32x4 y = v[r][j] * rstd * gv[j] + bv[j]; xr[64 * j] = y; u32x2 w; w.x = pk2(y.x, y.y); w.y = pk2(y.z, y.w); o8[64 * j] = w; }
        }
    }
}
__device__ __forceinline__ void ph_x_to_bf16(const Ctx& c) {
    PHASE_IDS();
    const int gw = c.bid * NWAVES + wave, NGW = c.G * NWAVES;
    const float* xin = in_ptr(0);
    for (int m0 = gw; m0 < MTOK; m0 += 4 * NGW) {
        f32x4 y[4][4];
#pragma unroll
        for (int r = 0; r < 4; ++r) { const int mr = (m0 + r * NGW) < MTOK ? (m0 + r * NGW) : m0; const f32x4* xr = (const f32x4*)(xin + (size_t)mr * DM) + lane;
#pragma unroll
            for (int j = 0; j < 4; ++j) y[r][j] = xr[64 * j]; }
#pragma unroll
        for (int r = 0; r < 4; ++r) { const int m = m0 + r * NGW; if (m >= MTOK) break; u32x2* o8 = (u32x2*)(c_XN + (size_t)m * DM) + lane;
#pragma unroll
            for (int j = 0; j < 4; ++j) { u32x2 w; w.x = pk2(y[r][j].x, y[r][j].y); w.y = pk2(y[r][j].z, y[r][j].w); o8[64 * j] = w; } }
    }
}

__device__ __forceinline__ void ph_prep(const Ctx& c, int l) {
    LAS bf16* ACT = (LAS bf16*)c.lds;
    const float* mu = in_ptr(6) + l * 1792; const float* w0 = in_ptr(7) + l * 512; const float* wup = in_ptr(8) + l * 64 * 512;
    const float* a0 = in_ptr(9) + l * 512; const float* aup = in_ptr(10) + l * 64 * 512;
    const float* kkw = in_ptr(12) + l * 512; const float* kaw = in_ptr(13) + l * 512; const float* rkw = in_ptr(14) + l * 512;
    const float* convw = in_ptr(22) + l * 4 * 1536; const float* alog = in_ptr(23) + l * 4; const float* dtb = in_ptr(24) + l * 4;
    PHASE_IDS(); const bf16* Hm = c_Hm; const int h = wave;
    LAS bf16* RES = (LAS bf16*)(c.lds + 16384) + wave * 4096;
    const int mi = lane & 15, g4 = lane >> 4;
    bf16x8 wb[2][4][2];
#pragma unroll
    for (int mv = 0; mv < 2; ++mv)
#pragma unroll
        for (int nt = 0; nt < 4; ++nt)
#pragma unroll
            for (int ks = 0; ks < 2; ++ks) { const float* W = (mv ? aup : wup) + (size_t)(32 * ks + 8 * g4) * 512 + h * 64 + nt * 16 + mi;
                u32x4 pw; pw.x = pk2(W[0], W[512]); pw.y = pk2(W[1024], W[1536]); pw.z = pk2(W[2048], W[2560]); pw.w = pk2(W[3072], W[3584]); wb[mv][nt][ks] = __builtin_bit_cast(bf16x8, pw); }
    for (int tile = c.bid; tile < MH / 32; tile += c.G) {
        const int R0 = tile * 32, t0 = R0 & (SEQ - 1);
        __syncthreads();
#pragma unroll
        for (int e = tid; e < 32 * 128; e += 512) { const int tt = e >> 7, j = e & 127, col = 1536 + j, R = R0 + tt; const float z = bf2f(Hm[(size_t)R * HMW + col]);
            const float pv = (t0 + tt) > 0 ? bf2f(Hm[(size_t)(R - 1) * HMW + col]) : 0.f; const float s = z + mu[col] * (pv - z);
            ACT[((j < 64 ? 0 : 32) + tt) * 72 + (j & 63)] = (bf16)f2bf(j < 64 ? tanhf_(s) : s); }
        __syncthreads();
#pragma unroll
        for (int mv = 0; mv < 2; ++mv)
#pragma unroll
            for (int mt = 0; mt < 2; ++mt) {
                const bf16x8 af0 = *(const LAS bf16x8*)(ACT + (mv * 32 + mt * 16 + mi) * 72 + 8 * g4), af1 = *(const LAS bf16x8*)(ACT + (mv * 32 + mt * 16 + mi) * 72 + 32 + 8 * g4);
#pragma unroll
                for (int nt = 0; nt < 4; ++nt) {
                    f32x4 d = __builtin_amdgcn_mfma_f32_16x16x32_bf16(af0, wb[mv][nt][0], (f32x4){0.f, 0.f, 0.f, 0.f}, 0, 0, 0);
                    d = __builtin_amdgcn_mfma_f32_16x16x32_bf16(af1, wb[mv][nt][1], d, 0, 0, 0);
#pragma unroll
                    for (int i = 0; i < 4; ++i) RES[(mv * 32 + mt * 16 + 4 * g4 + i) * 64 + nt * 16 + mi] = (bf16)f2bf(d[i]);
                }
            }
        {
            const float bias = w0[tid];
#pragma unroll 1
            for (int tt = 0; tt < 32; ++tt) {
                const float acc = bias + bf2f(RES[tt * 64 + lane]);
                const float w = __expf(-0.6065306597126334f * sigmoidf_(acc));
                c_P6[((size_t)(R0 + tt) * 8 + h) * 384 + 64 + lane] = (bf16)f2bf(w);
            }
        }
        {
            const float bias = a0[tid], mur = mu[tid], muk = mu[512 + tid], muv = mu[1024 + tid], kk_ = kkw[tid], ka_ = kaw[tid], rk_ = rkw[tid];
            float pr = 0.f, pk = 0.f, pvv = 0.f;
            if (t0 > 0) { const bf16* hp = Hm + (size_t)(R0 - 1) * HMW; pr = bf2f(hp[tid]); pk = bf2f(hp[512 + tid]); pvv = bf2f(hp[1024 + tid]); }
#pragma unroll 1
            for (int tg = 0; tg < 4; ++tg) {
                bf16 zr8[8], zk8[8], zv8[8];
#pragma unroll
                for (int u = 0; u < 8; ++u) { const bf16* hp = Hm + (size_t)(R0 + tg * 8 + u) * HMW; zr8[u] = hp[tid]; zk8[u] = hp[512 + tid]; zv8[u] = hp[1024 + tid]; }
#pragma unroll
                for (int u = 0; u < 8; ++u) {
                    const int tt = tg * 8 + u;
                    const float a = sigmoidf_(bias + bf2f(RES[(32 + tt) * 64 + lane]));
                    const float zr = bf2f(zr8[u]), zk = bf2f(zk8[u]), zv = bf2f(zv8[u]);
                    const float r = zr + mur * (pr - zr), k = zk + muk * (pk - zk), v = zv + muv * (pvv - zv);
                    pr = zr; pk = zk; pvv = zv;
                    const float kx = k * kk_; const float ss = wave_sum(kx * kx); const float kk = kx * __builtin_amdgcn_rsqf(ss + 1e-6f);
                    const float kt = k * (1.0f + (a - 1.0f) * ka_);
                    const float bn = wave_sum(r * kt * rk_);
                    bf16* q = c_P6 + ((size_t)(R0 + tt) * 8 + h) * 384 + lane;
                    q[0] = (bf16)f2bf(r); q[128] = (bf16)f2bf(kt); q[192] = (bf16)f2bf(v); q[256] = (bf16)f2bf(kk); q[320] = (bf16)f2bf(kk * a);
                    if (lane == 0) c_BON[(size_t)(R0 + tt) * 8 + h] = bn;
                }
            }
        }
        for (int tk = wave; tk < 24; tk += 8) {
            const int kh = tk % 12, th = tk / 12, kind = kh >> 2, head = kh & 3, ch = kind * 512 + head * 128 + 2 * lane;
            float cw[4][2];
#pragma unroll
            for (int j = 0; j < 4; ++j) { cw[j][0] = convw[j * 1536 + ch]; cw[j][1] = convw[j * 1536 + ch + 1]; }
            const int Rs = R0 + 16 * th, ts = t0 + 16 * th;
            float x[3][2];
#pragma unroll
            for (int k = 0; k < 3; ++k) { x[k][0] = 0.f; x[k][1] = 0.f; if (ts - 3 + k >= 0) { const unsigned u = *(const unsigned*)(Hm + (size_t)(Rs - 3 + k) * HMW + C_GD + ch); x[k][0] = bflo(u); x[k][1] = bfhi(u); } }
            unsigned uu[16];
#pragma unroll
            for (int i = 0; i < 16; ++i) uu[i] = *(const unsigned*)(Hm + (size_t)(Rs + i) * HMW + C_GD + ch);
#pragma unroll
            for (int i = 0; i < 16; ++i) {
                const float z0 = bflo(uu[i]), z1 = bfhi(uu[i]);
                float y0 = cw[0][0] * x[0][0] + cw[1][0] * x[1][0] + cw[2][0] * x[2][0] + cw[3][0] * z0;
                float y1 = cw[0][1] * x[0][1] + cw[1][1] * x[1][1] + cw[2][1] * x[2][1] + cw[3][1] * z1;
                x[0][0] = x[1][0]; x[0][1] = x[1][1]; x[1][0] = x[2][0]; x[1][1] = x[2][1]; x[2][0] = z0; x[2][1] = z1;
                y0 = siluf_(y0); y1 = siluf_(y1);
                if (kind < 2) { const float ss = wave_sum(y0 * y0 + y1 * y1); float sc = __builtin_amdgcn_rsqf(ss + 1e-6f); if (kind == 0) sc *= 0.08838834764831845f; y0 *= sc; y1 *= sc;
                    *(unsigned*)(c_GQK + ((size_t)(Rs + i) * 4 + head) * 256 + kind * 128 + 2 * lane) = pk2(y0, y1); }
                else *(unsigned*)(c_GV + (size_t)(Rs + i) * 512 + head * 128 + 2 * lane) = pk2(y0, y1);
            }
        }
        if (tid < 128) { const int tt = tid >> 2, hh = tid & 3; const size_t R = R0 + tt; const float alg = bf2f(Hm[R * HMW + C_GDA + hh]), blg = bf2f(Hm[R * HMW + C_GDB + hh]);
            const float xs = alg + dtb[hh]; const float sp = xs > 20.f ? xs : log1pf(__expf(xs));
            c_GB[(R * 4 + hh) * 2] = __expf(-__expf(alog[hh]) * sp); c_GB[(R * 4 + hh) * 2 + 1] = sigmoidf_(blg); }
    }
}

__device__ __forceinline__ void rwkv_scan(const Ctx& c, int task, int lane, LAS unsigned char* wl) {
    const int rg = lane >> 4, sub = lane & 15;
    const int bh = task >> 4, row = (task & 15) * 4 + rg, bl = bh >> 3, h = bh & 7;
    const unsigned char* gsrc = (const unsigned char*)(c_P6 + ((size_t)bl * SEQ * 8 + h) * 384) + lane * 16;
    bf16* yo = c_Y + (size_t)bl * SEQ * YW + h * 64 + row;
    f32x2 sA = {0.f, 0.f}, sB = {0.f, 0.f};
    u32x4 st[16];
    const bool ld = lane < 48;
    if (ld) {
#pragma unroll
        for (int i = 0; i < 16; ++i) st[i] = *(const u32x4*)(gsrc + (size_t)i * 6144);
#pragma unroll
        for (int i = 0; i < 16; ++i) *(LAS u32x4*)(wl + lane * 16 + i * 768) = st[i];
    }
#pragma unroll 1
    for (int ch = 0; ch < SEQ / 16; ++ch) {
        const int t0 = ch * 16; const bool more = ch + 1 < SEQ / 16;
        LAS unsigned char* rb = wl + (ch & 1) * 12288;
        float yb[16];
        if (ld && more) {
#pragma unroll
            for (int i = 0; i < 16; ++i) st[i] = *(const u32x4*)(gsrc + (size_t)(t0 + 16 + i) * 6144);
        }
        u32x2 nr = *(const LAS u32x2*)(rb + sub * 8), nw = *(const LAS u32x2*)(rb + 128 + sub * 8), nk = *(const LAS u32x2*)(rb + 256 + sub * 8);
        u32x2 nkk = *(const LAS u32x2*)(rb + 512 + sub * 8), nka = *(const LAS u32x2*)(rb + 640 + sub * 8);
        bf16 nv = *(const LAS bf16*)(rb + 384 + row * 2);
        float pyv = 0.f;
#pragma unroll
        for (int i = 0; i < 16; ++i) {
            const u32x2 dr = nr, dw = nw, dk = nk, dkk = nkk, dka = nka; const float v = bf2f(nv);
            if (i + 1 < 16) { LAS unsigned char* q = rb + (i + 1) * 768;
                nr = *(const LAS u32x2*)(q + sub * 8); nw = *(const LAS u32x2*)(q + 128 + sub * 8); nk = *(const LAS u32x2*)(q + 256 + sub * 8);
                nkk = *(const LAS u32x2*)(q + 512 + sub * 8); nka = *(const LAS u32x2*)(q + 640 + sub * 8); nv = *(const LAS bf16*)(q + 384 + row * 2); }
            const f32x2 kk01 = {bflo(dkk.x), bfhi(dkk.x)}, kk23 = {bflo(dkk.y), bfhi(dkk.y)}, w01 = {bflo(dw.x), bfhi(dw.x)}, w23 = {bflo(dw.y), bfhi(dw.y)};
            const f32x2 k01 = {bflo(dk.x), bfhi(dk.x)}, k23 = {bflo(dk.y), bfhi(dk.y)}, ka01 = {bflo(dka.x), bfhi(dka.x)}, ka23 = {bflo(dka.y), bfhi(dka.y)};
            const f32x2 r01 = {bflo(dr.x), bfhi(dr.x)}, r23 = {bflo(dr.y), bfhi(dr.y)};
            const f32x2 p = sA * kk01 + sB * kk23;
            float sk = p.x + p.y, yprev = pyv;
            row_sum16x2(sk, yprev);
            if (i > 0) yb[i - 1] = yprev;
            sA = sA * w01 + (k01 * v - ka01 * sk);
            sB = sB * w23 + (k23 * v - ka23 * sk);
            const f32x2 py = sA * r01 + sB * r23;
            pyv = py.x + py.y;
        }
        yb[15] = row_sum16(pyv);
        if (sub == 0) {
#pragma unroll
            for (int i = 0; i < 16; ++i) yo[(size_t)(t0 + i) * YW] = (bf16)f2bf(yb[i]);
        }
        if (ld && more) {
            LAS unsigned char* wb = wl + ((ch + 1) & 1) * 12288 + lane * 16;
#pragma unroll
            for (int i = 0; i < 16; ++i) *(LAS u32x4*)(wb + i * 768) = st[i];
        }
    }
}
__device__ __forceinline__ void gdn_scan(const Ctx& c, int task, int lane, LAS unsigned char* wl) {
    const int rg = lane >> 4, sub = lane & 15;
    const int bh = task >> 5, cg4 = (task & 31) * 4, col = cg4 + rg, bl = bh >> 2, h = bh & 3;
    const unsigned char* gqk = (const unsigned char*)(c_GQK + ((size_t)bl * SEQ * 4 + h) * 256) + lane * 16;
    const unsigned char* gvb = lane < 16 ? (const unsigned char*)(c_GV + ((size_t)bl * SEQ + lane) * 512 + h * 128 + cg4)
                                         : (const unsigned char*)(c_GB + (((size_t)bl * SEQ + (lane - 16)) * 4 + h) * 2);
    const size_t vstep = lane < 16 ? 1024 : 32;
    bf16* yo = c_Y + (size_t)bl * SEQ * YW + 1024 + h * 128 + col;
    f32x2 g0 = {0.f, 0.f}, g1 = {0.f, 0.f}, g2 = {0.f, 0.f}, g3 = {0.f, 0.f};
    u32x4 st[16]; u32x2 sv;
    const bool ld = lane < 32;
    constexpr int BUF = 8192 + 256;
    if (ld) {
#pragma unroll
        for (int i = 0; i < 16; ++i) st[i] = *(const u32x4*)(gqk + (size_t)i * 2048);
        sv = *(const u32x2*)gvb;
#pragma unroll
        for (int i = 0; i < 16; ++i) *(LAS u32x4*)(wl + lane * 16 + i * 512) = st[i];
        *(LAS u32x2*)(wl + 8192 + lane * 8) = sv;
    }
#pragma unroll 1
    for (int ch = 0; ch < SEQ / 16; ++ch) {
        const int t0 = ch * 16; const bool more = ch + 1 < SEQ / 16;
        LAS unsigned char* rb = wl + (ch & 1) * BUF;
        float yb[16];
        if (ld && more) {
#pragma unroll
            for (int i = 0; i < 16; ++i) st[i] = *(const u32x4*)(gqk + (size_t)(t0 + 16 + i) * 2048);
            sv = *(const u32x2*)(gvb + (size_t)(t0 + 16) * vstep);
        }
        u32x4 nq = *(const LAS u32x4*)(rb + sub * 16), nk = *(const LAS u32x4*)(rb + 256 + sub * 16);
        bf16 nv = *(const LAS bf16*)(rb + 8192 + rg * 2); f32x2 ngb = *(const LAS f32x2*)(rb + 8192 + 128);
        float pov = 0.f;
#pragma unroll
        for (int i = 0; i < 16; ++i) {
            const u32x4 dq = nq, dk = nk; const float v = bf2f(nv); const f32x2 gb = ngb;
            if (i + 1 < 16) { nq = *(const LAS u32x4*)(rb + (i + 1) * 512 + sub * 16); nk = *(const LAS u32x4*)(rb + (i + 1) * 512 + 256 + sub * 16);
                nv = *(const LAS bf16*)(rb + 8192 + (i + 1) * 8 + rg * 2); ngb = *(const LAS f32x2*)(rb + 8192 + 128 + (i + 1) * 8); }
            const f32x2 k01 = {bflo(dk.x), bfhi(dk.x)}, k23 = {bflo(dk.y), bfhi(dk.y)}, k45 = {bflo(dk.z), bfhi(dk.z)}, k67 = {bflo(dk.w), bfhi(dk.w)};
            const f32x2 q01 = {bflo(dq.x), bfhi(dq.x)}, q23 = {bflo(dq.y), bfhi(dq.y)}, q45 = {bflo(dq.z), bfhi(dq.z)}, q67 = {bflo(dq.w), bfhi(dq.w)};
            const float eg = gb.x, beta = gb.y;
            const f32x2 p = (g0 * k01 + g1 * k23) + (g2 * k45 + g3 * k67);
            float ks = p.x + p.y, oprev = pov;
            row_sum16x2(ks, oprev);
            if (i > 0) yb[i - 1] = oprev;
            const float u = beta * (v - eg * ks);
            g0 = g0 * eg + k01 * u; g1 = g1 * eg + k23 * u; g2 = g2 * eg + k45 * u; g3 = g3 * eg + k67 * u;
            const f32x2 po = (g0 * q01 + g1 * q23) + (g2 * q45 + g3 * q67);
            pov = po.x + po.y;
        }
        yb[15] = row_sum16(pov);
        if (sub == 0) {
#pragma unroll
            for (int i = 0; i < 16; ++i) yo[(size_t)(t0 + i) * YW] = (bf16)f2bf(yb[i]);
        }
        if (ld && more) {
            LAS unsigned char* wb = wl + ((ch + 1) & 1) * BUF;
#pragma unroll
            for (int i = 0; i < 16; ++i) *(LAS u32x4*)(wb + lane * 16 + i * 512) = st[i];
            *(LAS u32x2*)(wb + 8192 + lane * 8) = sv;
        }
    }
}
__device__ __forceinline__ void attn_tile(const Ctx& c, int lane, int bh, int qt, float lam, float lam_init, const float* ng) {
    const int qi = lane & 15, g = lane >> 4;
    const int bl = bh >> 2, h = bh & 3, q0 = qt * 16;
    const bf16* Hb = c_Hm + (size_t)bl * SEQ * HMW;
    bf16x8 qf[2][2];
#pragma unroll
    for (int m = 0; m < 2; ++m)
#pragma unroll
        for (int s = 0; s < 2; ++s) qf[m][s] = *(const bf16x8*)(Hb + (size_t)(q0 + qi) * HMW + C_DA + h * 128 + m * 64 + s * 32 + g * 8);
    const bf16* Kb = Hb + C_DAK + h * 128 + g * 8;
    const bf16* Vb = c_Vt + ((size_t)(bl * 4 + h) * 128 + qi) * SEQ + 8 * g;
    const int krow = 8 * (qi >> 2) + (qi & 3);
    f32x4 O[2][8];
#pragma unroll
    for (int m = 0; m < 2; ++m)
#pragma unroll
        for (int d = 0; d < 8; ++d) O[m][d] = (f32x4){0.f, 0.f, 0.f, 0.f};
    float Mx[2] = {-1e30f, -1e30f}, L[2] = {0.f, 0.f};
    const float c1 = 0.125f * 1.4426950408889634f;
    const float c2 = exp2f(-2.0f * (float)(h + 1)) * 1.4426950408889634f;
    const int nb = qt / 2 + 1;
    for (int blk = nb - 1; blk >= 0; --blk) {
        const int kb = blk * 32;
        bf16x8 kf[2][2][2], vf[8];
#pragma unroll
        for (int m = 0; m < 2; ++m)
#pragma unroll
            for (int ta = 0; ta < 2; ++ta)
#pragma unroll
                for (int s = 0; s < 2; ++s) kf[m][ta][s] = *(const bf16x8*)(Kb + (size_t)(kb + krow + 4 * ta) * HMW + m * 64 + s * 32);
#pragma unroll
        for (int d = 0; d < 8; ++d) vf[d] = *(const bf16x8*)(Vb + (size_t)d * 16 * SEQ + kb);
        const int base = kb + 8 * g - (q0 + qi);
        const float fb = c2 * (float)base;
        bf16x8 pf[2];
#pragma unroll
        for (int m = 0; m < 2; ++m) {
            f32x4 S[2];
#pragma unroll
            for (int ta = 0; ta < 2; ++ta) { S[ta] = __builtin_amdgcn_mfma_f32_16x16x32_bf16(kf[m][ta][0], qf[m][0], (f32x4){0.f, 0.f, 0.f, 0.f}, 0, 0, 0); S[ta] = __builtin_amdgcn_mfma_f32_16x16x32_bf16(kf[m][ta][1], qf[m][1], S[ta], 0, 0, 0); }
            float x[8]; float mx = -1e30f;
#pragma unroll
            for (int ta = 0; ta < 2; ++ta)
#pragma unroll
                for (int i = 0; i < 4; ++i) { const int dd = base + 4 * ta + i; float v = S[ta][i] * c1 + (fb + c2 * (float)(4 * ta + i)); v = dd > 0 ? -1e30f : v; x[ta * 4 + i] = v; mx = fmaxf(mx, v); }
            mx = fmaxf(mx, __shfl_xor(mx, 16)); mx = fmaxf(mx, __shfl_xor(mx, 32));
            const float mn = fmaxf(Mx[m], mx), al = __builtin_amdgcn_exp2f(Mx[m] - mn);
            float rs = 0.f;
#pragma unroll
            for (int j = 0; j < 8; ++j) { x[j] = __builtin_amdgcn_exp2f(x[j] - mn); rs += x[j]; }
            if (__builtin_amdgcn_ballot_w64(mn != Mx[m]) != 0ull) {
                L[m] = L[m] * al; Mx[m] = mn;
#pragma unroll
                for (int d = 0; d < 8; ++d) O[m][d] = O[m][d] * al;
            }
            L[m] += rs;
            u32x4 pw; pw.x = pk2(x[0], x[1]); pw.y = pk2(x[2], x[3]); pw.z = pk2(x[4], x[5]); pw.w = pk2(x[6], x[7]);
            pf[m] = __builtin_bit_cast(bf16x8, pw);
        }
#pragma unroll
        for (int d = 0; d < 8; ++d) { O[0][d] = __builtin_amdgcn_mfma_f32_16x16x32_bf16(vf[d], pf[0], O[0][d], 0, 0, 0); O[1][d] = __builtin_amdgcn_mfma_f32_16x16x32_bf16(vf[d], pf[1], O[1][d], 0, 0, 0); }
    }
    float l0 = L[0]; l0 += __shfl_xor(l0, 16); l0 += __shfl_xor(l0, 32);
    float l1 = L[1]; l1 += __shfl_xor(l1, 16); l1 += __shfl_xor(l1, 32);
    const float i0 = 1.0f / l0, i1 = lam / l1;
    float ss = 0.f;
#pragma unroll
    for (int d = 0; d < 8; ++d) { O[0][d] = O[0][d] * i0 - O[1][d] * i1; ss += (O[0][d][0] * O[0][d][0] + O[0][d][1] * O[0][d][1]) + (O[0][d][2] * O[0][d][2] + O[0][d][3] * O[0][d][3]); }
    ss += __shfl_xor(ss, 16); ss += __shfl_xor(ss, 32);
    const float sc = __builtin_amdgcn_rsqf(ss * (1.0f / 128.0f) + 1e-5f) * (1.0f - lam_init);
    bf16* yo = c_Y + (size_t)(bl * SEQ + q0 + qi) * YW + 512 + h * 128 + 4 * g;
#pragma unroll
    for (int d = 0; d < 8; ++d) { const f32x4 gg = *(const f32x4*)(ng + 16 * d + 4 * g); const f32x4 o = O[0][d] * sc * gg; u32x2 w; w.x = pk2(o[0], o[1]); w.y = pk2(o[2], o[3]); *(u32x2*)(yo + 16 * d) = w; }
}
__device__ __forceinline__ void ph_mix(const Ctx& c, int l, int roles) {
    PHASE_IDS();
    if (wave < 2) {
        if (!(roles & 1)) return;
#if !SKIP_RW
        __builtin_amdgcn_s_setprio(3);
        for (int task = c.bid * 2 + wave; task < 512; task += c.G * 2) rwkv_scan(c, task, lane, c.lds + wave * 24576);
        __builtin_amdgcn_s_setprio(0);
#endif
    } else if (wave < 4) {
        if (!(roles & 2)) return;
#if !SKIP_GD
        __builtin_amdgcn_s_setprio(3);
        for (int task = c.bid * 2 + (wave - 2); task < 512; task += c.G * 2) gdn_scan(c, task, lane, c.lds + wave * 24576);
        __builtin_amdgcn_s_setprio(0);
#endif
    } else {
        if (!(roles & 4)) return;
#if !SKIP_DA
        const float lam_init = 0.8f - 0.6f * __expf(-0.3f * (float)l);
        const float d1 = wave_sum(in_ptr(17)[l * 64 + lane] * in_ptr(18)[l * 64 + lane]), d2 = wave_sum(in_ptr(19)[l * 64 + lane] * in_ptr(20)[l * 64 + lane]);
        const float lam = __expf(d1) - __expf(d2) + lam_init;
        const float* ng = in_ptr(21) + l * 128;
        if (wave >= 6) return;
        for (int p = c.bid * 2 + (wave - 4); p < 2048; p += c.G * 2) { const int bh = p >> 7, j = p & 127; attn_tile(c, lane, bh, 255 - j, lam, lam_init, ng); attn_tile(c, lane, bh, j, lam, lam_init, ng); }
#endif
    }
}

__device__ __forceinline__ void ph_post(const Ctx& c, int l) {
    LAS bf16* ACT = (LAS bf16*)c.lds;
    const float* mu = in_ptr(6) + l * 1792; const float* gup = in_ptr(11) + l * 128 * 512;
    const float* lng = in_ptr(15) + l * 512; const float* lnb = in_ptr(16) + l * 512; const float* gng = in_ptr(25) + l * 128;
    PHASE_IDS(); const bf16* Hm = c_Hm; const int h = wave;
    LAS bf16* RES = (LAS bf16*)(c.lds + 16384) + wave * 2048;
    const int mi = lane & 15, g4 = lane >> 4;
    bf16x8 wb[4][4];
#pragma unroll
    for (int nt = 0; nt < 4; ++nt)
#pragma unroll
        for (int ks = 0; ks < 4; ++ks) { const float* W = gup + (size_t)(32 * ks + 8 * g4) * 512 + h * 64 + nt * 16 + mi;
            u32x4 pw; pw.x = pk2(W[0], W[512]); pw.y = pk2(W[1024], W[1536]); pw.z = pk2(W[2048], W[2560]); pw.w = pk2(W[3072], W[3584]); wb[nt][ks] = __builtin_bit_cast(bf16x8, pw); }
    for (int tile = c.bid; tile < MH / 32; tile += c.G) {
        const int R0 = tile * 32, t0 = R0 & (SEQ - 1);
        __syncthreads();
#pragma unroll
        for (int e = tid; e < 32 * 128; e += 512) { const int tt = e >> 7, j = e & 127, col = 1664 + j, R = R0 + tt; const float z = bf2f(Hm[(size_t)R * HMW + col]);
            const float pv = (t0 + tt) > 0 ? bf2f(Hm[(size_t)(R - 1) * HMW + col]) : 0.f; ACT[tt * 136 + j] = (bf16)f2bf(sigmoidf_(z + mu[col] * (pv - z))); }
        __syncthreads();
#pragma unroll
        for (int mt = 0; mt < 2; ++mt) {
            bf16x8 af[4];
#pragma unroll
            for (int ks = 0; ks < 4; ++ks) af[ks] = *(const LAS bf16x8*)(ACT + (mt * 16 + mi) * 136 + 32 * ks + 8 * g4);
#pragma unroll
            for (int nt = 0; nt < 4; ++nt) {
                f32x4 d = (f32x4){0.f, 0.f, 0.f, 0.f};
#pragma unroll
                for (int ks = 0; ks < 4; ++ks) d = __builtin_amdgcn_mfma_f32_16x16x32_bf16(af[ks], wb[nt][ks], d, 0, 0, 0);
#pragma unroll
                for (int i = 0; i < 4; ++i) RES[(mt * 16 + 4 * g4 + i) * 64 + nt * 16 + mi] = (bf16)f2bf(d[i]);
            }
        }
        {
            const float muv = mu[1024 + tid], lg = lng[tid], lb = lnb[tid];
            float pvv = 0.f; if (t0 > 0) pvv = bf2f(Hm[(size_t)(R0 - 1) * HMW + 1024 + tid]);
#pragma unroll 1
            for (int tg = 0; tg < 4; ++tg) {
                bf16 y8[8], zv8[8]; float bn8[8];
#pragma unroll
                for (int u = 0; u < 8; ++u) { const size_t R = R0 + tg * 8 + u; y8[u] = c_Y[R * YW + tid]; zv8[u] = Hm[R * HMW + 1024 + tid]; bn8[u] = c_BON[R * 8 + h]; }
#pragma unroll
                for (int u = 0; u < 8; ++u) {
                    const int tt = tg * 8 + u;
                    const float acc = bf2f(RES[tt * 64 + lane]);
                    const size_t R = R0 + tt;
                    const float y = bf2f(y8[u]);
                    const float mean = wave_sum(y) * (1.0f / 64.0f), d = y - mean, var = wave_sum(d * d) * (1.0f / 64.0f);
                    const float yn = d * __builtin_amdgcn_rsqf(var + 64e-5f) * lg + lb;
                    const float zv = bf2f(zv8[u]); const float v = zv + muv * (pvv - zv); pvv = zv;
                    float o = (yn + bn8[u] * v) * acc;
#if SKIP_RW
                    o = 0.f;
#endif
                    c_Y[R * YW + tid] = (bf16)f2bf(o);
                }
            }
        }
        {
            unsigned yu[4][4], zz[4][4];
#pragma unroll
            for (int a = 0; a < 4; ++a)
#pragma unroll
                for (int hh = 0; hh < 4; ++hh) { const size_t R = R0 + wave + 8 * a; yu[a][hh] = *(const unsigned*)(c_Y + R * YW + 1024 + hh * 128 + 2 * lane); zz[a][hh] = *(const unsigned*)(Hm + R * HMW + C_GDZ + hh * 128 + 2 * lane); }
            const float gn0 = gng[2 * lane], gn1 = gng[2 * lane + 1];
#pragma unroll
            for (int a = 0; a < 4; ++a) {
                const size_t R = R0 + wave + 8 * a;
#pragma unroll
                for (int hh = 0; hh < 4; ++hh) {
                    const float o0 = bflo(yu[a][hh]), o1 = bfhi(yu[a][hh]);
                    const float ss = wave_sum(o0 * o0 + o1 * o1) * (1.0f / 128.0f), sc = __builtin_amdgcn_rsqf(ss + 1e-6f);
                    float r0 = o0 * sc * gn0 * siluf_(bflo(zz[a][hh])), r1 = o1 * sc * gn1 * siluf_(bfhi(zz[a][hh]));
#if SKIP_GD
                    r0 = 0.f; r1 = 0.f;
#endif
                    *(unsigned*)(c_Y + R * YW + 1024 + hh * 128 + 2 * lane) = pk2(r0, r1);
                }
#if SKIP_DA
                for (int e = lane; e < 256; e += 64) *(unsigned*)(c_Y + R * YW + 512 + 2 * e) = 0u;
#endif
            }
        }
    }
}

constexpr int PH_PER_LAYER = 20;
__global__ void __launch_bounds__(NWAVES * 64, 2) fwd_kernel(Params p) {
    extern __shared__ __attribute__((aligned(16))) unsigned char lds_raw[];
    cg::grid_group grid = cg::this_grid();
    if (p.ph_hi < 0) grid.sync();
    Ctx c;
    c.lds = (LAS unsigned char*)lds_raw; c.wv = __builtin_amdgcn_readfirstlane(threadIdx.x >> 6); c.G = gridDim.x; c.bid = blockIdx.x;
    c.X = p.out; c.ws = p.ws;
    volatile LAS unsigned* bst = (volatile LAS unsigned*)(c.lds + 131072 + 512);
    { const int t_ = threadIdx.x; if (t_ < 2) bst[t_] = 0u; }
    __syncthreads();
    const XcdBarrier bar = xcd_barrier_post((unsigned*)(p.ws + WS_BAR), bst);
    for (int ph = p.ph_lo; ph < p.ph_hi; ++ph) {
        const int l = ph / PH_PER_LAYER, k = ph % PH_PER_LAYER;
        pg8::TileOrder S;
#ifndef PHMASK
#define PHMASK 255
#endif
        if (k == 0 && l > 0) continue;
        int wl = -1, w_lo = 0, w_hi = 0, w_wb = 0, w_wc = NWAVES;
        if (l == 0 && k == 0) { wl = 0; w_hi = WI1 + WI2; }
        else if (l == 0 && k == 3) { wl = 0; w_lo = WI1 + WI2; w_hi = WNIT; w_wb = 4; w_wc = 4; }
        else if (l == 0 && k == 19) { wl = 1; w_hi = WNIT; w_wb = 4; w_wc = 4; }
        if (k == 0) ph_x_to_bf16(c);
        else if (k == 1 || k == 17) {
            pg8::Gemm g{c_XN, c_W + (k == 1 ? W_1 : W_3), DM, DM}; S.init(MTOK, 2 * DFF, c.G, c.bid, 1);
            pg8::EpiSwiglu E{c_HB}; pg8::gemm_phase(c.lds, g, S, E, c.wv);
        } else if (k == 2 || k == 18) {
            pg8::Gemm g{c_HB, c_W + (k == 2 ? W_2 : W_4), DFF, DFF}; S.init(MTOK, DM, c.G, c.bid, 1);
            pg8::EpiResid E{(l == 0 && k == 2) ? in_ptr(0) : c.X, c.X, ALPHA, 0.5f}; pg8::gemm_phase(c.lds, g, S, E, c.wv);
        } else if (k == 3) ph_ln(c, in_ptr(3) + l * DM, in_ptr(4) + l * DM, l == 0 ? 4 : NWAVES);
        else if (k == 16) ph_ln(c, in_ptr(28) + l * DM, in_ptr(29) + l * DM, NWAVES);
        else if (k == 19) ph_ln(c, in_ptr(32) + l * DM, in_ptr(33) + l * DM, l == 0 ? 4 : NWAVES);
        else {
            const int hb = (k - 4) / 6, kk = (k - 4) % 6;
            const bf16* XNh = c_XN + (size_t)hb * MH * DM; float* Xh = c.X + (size_t)hb * MH * DM;
#if SKIP_MIX
            if (kk == 5) { pg8::Gemm g{XNh, c_W + W_O, DM, DM}; S.init(MH, DM, c.G, c.bid, 1); pg8::EpiResid E{Xh, Xh, ALPHA, 0.0f}; pg8::gemm_phase(c.lds, g, S, E, c.wv); }
#else
            if (kk == 0) { pg8::Gemm g{XNh, c_W + W_M, DM, DM}; S.init(MH, HMW, c.G, c.bid, 1); pg8::EpiHm E{c_Hm, c_Vt, HMW, 11}; pg8::gemm_phase(c.lds, g, S, E, c.wv); }
            else if (kk == 1) { if (PHMASK & 2) { ph_prep(c, l);
#ifdef REPEAT_PREP
                ph_prep(c, l);
#endif
            } }
            else if (kk == 2) { if (PHMASK & 4) { ph_mix(c, l, 7);
#ifdef REPEAT_MIX
                ph_mix(c, l, REPEAT_MIX);
#endif
            } }
            else if (kk == 3) { if (PHMASK & 8) ph_post(c, l);
                __syncthreads();
                pg8::Gemm g{XNh, c_W + W_G, DM, DM}; S.init(MH, HGW, c.G, c.bid, 1); pg8::EpiHm E{c_Hg, c_Vt, HGW, 1 << 20}; pg8::gemm_phase(c.lds, g, S, E, c.wv); }
            else if (kk == 4) { pg8::Gemm g{c_Y, c_W + W_B, YW, 512}; S.init(MH, DM, c.G, c.bid, 3); pg8::EpiMerge E{c_Hg, c_Mg}; pg8::gemm_phase(c.lds, g, S, E, c.wv); }
            else { pg8::Gemm g{c_Mg, c_W + W_O, DM, DM}; S.init(MH, DM, c.G, c.bid, 1); pg8::EpiResid E{Xh, Xh, ALPHA, 1.0f}; pg8::gemm_phase<pg8::EpiResid, 16>(c.lds, g, S, E, c.wv); }
#endif
        }
        if (wl >= 0) ph_weights(c, wl, w_lo, w_hi, w_wb, w_wc);
        if (ph + 1 < p.ph_hi || DBG_DUMP) {
#if USE_CG_SYNC
            __builtin_amdgcn_fence(__ATOMIC_RELEASE, "agent"); asm volatile("s_waitcnt vmcnt(0) lgkmcnt(0)" ::: "memory");
            grid.sync();
            __builtin_amdgcn_fence(__ATOMIC_ACQUIRE, "agent"); asm volatile("s_waitcnt vmcnt(0)" ::: "memory");
#else
            xcd_barrier(bar, c.wv);
#endif
        }
    }
#if DBG_DUMP
    {
        const bf16* src = (const bf16*)(p.ws + DBG_SRC);
        const size_t n = (size_t)DBG_N, tot = (size_t)MTOK * DM;
        for (size_t i = (size_t)blockIdx.x * 512 + threadIdx.x; i < tot; i += (size_t)gridDim.x * 512) p.out[i] = i < n ? bf2f(src[i]) : 0.f;
    }
#endif
}

extern "C" void kernel_launch(void* const* d_in, const int* in_sizes, int n_in, void* d_out, int out_size, void* d_ws, size_t ws_size, hipStream_t stream) {
    static int grid = 0;
    if (grid == 0) {
        if (n_in != 34 || out_size != MTOK * DM || ws_size < WS_END) { fprintf(stderr, "kernel_launch: unexpected problem (n_in %d out %d ws %zu)\n", n_in, out_size, ws_size); grid = -1; return; }
        int dev = 0, cus = 0, per_cu = 0;
        hipGetDevice(&dev); hipDeviceGetAttribute(&cus, hipDeviceAttributeMultiprocessorCount, dev);
        hipFuncSetAttribute((const void*)fwd_kernel, hipFuncAttributeMaxDynamicSharedMemorySize, LDS_BYTES);
        hipOccupancyMaxActiveBlocksPerMultiprocessor(&per_cu, (const void*)fwd_kernel, NWAVES * 64, LDS_BYTES);
        if (per_cu < 1) per_cu = 1;
        grid = cus * per_cu; if (grid > 256) grid = 256;
        (void)hipGetLastError();
    }
    if (grid < 0) return;
    if (hipMemsetAsync((char*)d_ws + WS_BAR, 0, XCD_BAR_WORDS * 4, stream) != hipSuccess) { fprintf(stderr, "memset failed\n"); return; }
    Params p{};
    for (int i = 0; i < 34; ++i) p.in[i] = (const float*)d_in[i];
    p.out = (float*)d_out; p.ws = (unsigned char*)d_ws; p.ph_lo = 0; p.ph_hi = DBG_HI;
    void* args[] = {&p};
    hipError_t e = hipLaunchCooperativeKernel((const void*)fwd_kernel, dim3(grid), dim3(NWAVES * 64), args, LDS_BYTES, stream);
    if (e != hipSuccess) fprintf(stderr, "cooperative launch failed: %s (grid %d)\n", hipGetErrorString(e), grid);
}
```

```cpp
#include <hip/hip_runtime.h>
#include <hip/hip_cooperative_groups.h>
#include <cstdio>
#include <cstdint>
namespace cg = cooperative_groups;

#define LAS __attribute__((address_space(3)))
typedef unsigned short bf16;
typedef short bf16x8 __attribute__((ext_vector_type(8)));
typedef float f32x4 __attribute__((ext_vector_type(4)));
typedef float f32x2 __attribute__((ext_vector_type(2)));
typedef unsigned u32x4 __attribute__((ext_vector_type(4)));
typedef unsigned u32x2 __attribute__((ext_vector_type(2)));

#ifndef USE_CG_SYNC
#define USE_CG_SYNC 0
#endif
#ifndef DBG_DUMP
#define DBG_DUMP 0
#define DBG_SRC 0
#define DBG_N 0
#define DBG_HI (2 * PH_PER_LAYER)
#endif
#ifndef SKIP_RW
#define SKIP_RW 0
#endif
#ifndef SKIP_DA
#define SKIP_DA 0
#endif
#ifndef SKIP_GD
#define SKIP_GD 0
#endif
#ifndef SKIP_MIX
#define SKIP_MIX 0
#endif

constexpr int MTOK = 32768, MH = 16384, DM = 1024, DFF = 2816, SEQ = 4096;
constexpr int HMW = 5632;
constexpr int HGW = 3072;
constexpr int YW = 1536;
constexpr int NWAVES = 8;
constexpr int LDS_BYTES = 131072 + 1024;
constexpr float ALPHA = 1.41421356237f;

constexpr int C_RW = 0, C_DA = 1792, C_DAK = 2304, C_DAV = 2816, C_GD = 3328, C_GDA = 4864, C_GDB = 4868, C_GDZ = 4872;

constexpr size_t MiB = 1u << 20;
constexpr size_t WS_BON = 0;
constexpr size_t WS_GB = 1 * MiB;
constexpr size_t WS_BAR = 2 * MiB;
constexpr size_t WS_W = 4 * MiB;
constexpr size_t WS_XN = 60 * MiB;
constexpr size_t WS_A = 124 * MiB;
constexpr size_t WS_B = 300 * MiB;
constexpr size_t WS_P6 = WS_B, WS_GQK = WS_B + 96 * MiB, WS_GV = WS_B + 128 * MiB, WS_VT = WS_B + 144 * MiB;
constexpr size_t WS_C = 460 * MiB;
constexpr size_t WS_END = 508 * MiB;
constexpr size_t W_1 = 0, W_2 = 5767168, W_M = 8650752, W_G = 14417920, W_B = 17563648, W_O = 19136512, W_3 = 20185088, W_4 = 25952256;

__device__ __forceinline__ float bf2f(bf16 b) { return __uint_as_float((unsigned)b << 16); }
__device__ __forceinline__ float bflo(unsigned u) { return __uint_as_float(u << 16); }
__device__ __forceinline__ float bfhi(unsigned u) { return __uint_as_float(u & 0xffff0000u); }
typedef __bf16 bf16x2_t __attribute__((ext_vector_type(2)));
__device__ __forceinline__ unsigned pk2(float lo, float hi) { const f32x2 v = {lo, hi}; const bf16x2_t b = __builtin_convertvector(v, bf16x2_t); return __builtin_bit_cast(unsigned, b); }
__device__ __forceinline__ unsigned f2bf(float f) { return pk2(f, f) & 0xffffu; }
__device__ __forceinline__ float sigmoidf_(float x) { return __builtin_amdgcn_rcpf(1.0f + __expf(-x)); }
__device__ __forceinline__ float siluf_(float x) { return x * sigmoidf_(x); }
__device__ __forceinline__ float tanhf_(float x) { return 1.0f - 2.0f * __builtin_amdgcn_rcpf(__expf(2.0f * x) + 1.0f); }
template <int CTRL> __device__ __forceinline__ float dppf(float x) { return __int_as_float(__builtin_amdgcn_update_dpp(0, __float_as_int(x), CTRL, 0xf, 0xf, false)); }
__device__ __forceinline__ float row_sum16(float x) {
    x += dppf<0x128>(x); x += dppf<0x124>(x); x += dppf<0x122>(x); x += dppf<0x121>(x); return x;
}


#define XB_TMO      128
#define XB_XCNT(j)  (256  + 64 * (j))
#define XB_XSUB(j)  (1280 + 64 * (j))
#define XB_XGEN(j)  (2304 + 64 * (j))
#define XB_TOP      3328
#define XB_TOPGEN   3392
#define XCD_BAR_WORDS 3456
#define XB_SPIN_CAP (1u << 22)
__device__ __forceinline__ unsigned xb_ld(unsigned* p)              { return __hip_atomic_load(p, __ATOMIC_RELAXED, __HIP_MEMORY_SCOPE_AGENT); }
__device__ __forceinline__ unsigned xb_add(unsigned* p, unsigned v) { return __hip_atomic_fetch_add(p, v, __ATOMIC_RELAXED, __HIP_MEMORY_SCOPE_AGENT); }
__device__ __forceinline__ unsigned xb_xcc_id() { return (unsigned)__builtin_amdgcn_s_getreg((3 << 11) | 20) & 0xFu; }
#define XB_SPIN(cond, bar) do { unsigned _sp = 0; while (cond) { __builtin_amdgcn_s_sleep(1); \
    if ((++_sp & 255u) == 0u) { if (xb_ld(&(bar)[XB_TMO])) break; if (_sp > XB_SPIN_CAP) { atomicAdd(&(bar)[XB_TMO], 1u); break; } } } } while (0)
struct XcdBarrier { unsigned* bar; unsigned x; volatile LAS unsigned* st; };
__device__ __forceinline__ XcdBarrier xcd_barrier_post(unsigned* bar, volatile LAS unsigned* st) {
    XcdBarrier b; b.bar = bar; b.x = xb_xcc_id(); b.st = st;
    if (threadIdx.x == 0) (void)xb_add(&bar[XB_XCNT(b.x)], 1u);
    return b;
}
__device__ __forceinline__ void xcd_barrier_complete(unsigned* bar, unsigned x, unsigned& nloc, unsigned& nx) {
    const unsigned G = gridDim.x * gridDim.y * gridDim.z;
    unsigned sum, cnt, mine, sp = 0u;
    for (;;) {
        sum = 0u; cnt = 0u; mine = 0u;
#pragma unroll
        for (unsigned j = 0; j < 16; ++j) { const unsigned c = xb_ld(&bar[XB_XCNT(j)]); sum += c; cnt += (c > 0u) ? 1u : 0u; mine = (j == x) ? c : mine; }
        if (sum == G) break;
        __builtin_amdgcn_s_sleep(1);
        if ((++sp & 255u) == 0u) { if (xb_ld(&bar[XB_TMO])) break; if (sp > XB_SPIN_CAP) { atomicAdd(&bar[XB_TMO], 1u); break; } }
    }
    nloc = mine > 0u ? mine : 1u; nx = cnt > 0u ? cnt : 1u;
}
__device__ __forceinline__ void xcd_barrier(const XcdBarrier& b, const int wv) {
    asm volatile("s_waitcnt vmcnt(0)" ::: "memory");
    __syncthreads();
    if (wv == 0 && __builtin_amdgcn_mbcnt_hi(~0u, __builtin_amdgcn_mbcnt_lo(~0u, 0u)) == 0u) {
        unsigned* bar = b.bar;
        __builtin_amdgcn_s_waitcnt(0);
        unsigned nloc = b.st[0], nx = b.st[1];
        if (nloc == 0u) { xcd_barrier_complete(bar, b.x, nloc, nx); b.st[0] = nloc; b.st[1] = nx; }
        const unsigned old = xb_add(&bar[XB_XSUB(b.x)], 1u);
        const unsigned gen = old / nloc;
        if (old + 1u == (gen + 1u) * nloc) {
            __builtin_amdgcn_fence(__ATOMIC_RELEASE, "agent");
            asm volatile("s_waitcnt vmcnt(0)" ::: "memory");
            const unsigned og = xb_add(&bar[XB_TOP], 1u);
            const unsigned tg = og / nx;
            if (og + 1u == (tg + 1u) * nx) xb_add(&bar[XB_TOPGEN], 1u);
            else XB_SPIN(xb_ld(&bar[XB_TOPGEN]) == tg, bar);
            __builtin_amdgcn_fence(__ATOMIC_ACQUIRE, "agent");
            xb_add(&bar[XB_XGEN(b.x)], 1u);
            asm volatile("s_waitcnt vmcnt(0)" ::: "memory");
        } else {
            XB_SPIN(xb_ld(&bar[XB_XGEN(b.x)]) == gen, bar);
            __builtin_amdgcn_fence(__ATOMIC_ACQUIRE, "agent");
            asm volatile("s_waitcnt vmcnt(0)" ::: "memory");
        }
    }
    __syncthreads();
}

__device__ __forceinline__ void row_sum16x2(float& a, float& b) {
    a += dppf<0x128>(a); b += dppf<0x128>(b); a += dppf<0x124>(a); b += dppf<0x124>(b); a += dppf<0x122>(a); b += dppf<0x122>(b); a += dppf<0x121>(a); b += dppf<0x121>(b);
}
__device__ __forceinline__ float wave_sum(float v) {
    v = row_sum16(v);
    const int iv = __float_as_int(v);
    return (__int_as_float(__builtin_amdgcn_readlane(iv, 0)) + __int_as_float(__builtin_amdgcn_readlane(iv, 16))) + (__int_as_float(__builtin_amdgcn_readlane(iv, 32)) + __int_as_float(__builtin_amdgcn_readlane(iv, 48)));
}
namespace pg8 {
constexpr int BM = 256, BK = 64, HALF = 128, HTB = HALF * BK * 2, STAGE_BYTES = 8 * HTB, NXCD = 8, WGM = 8;
__host__ __device__ __forceinline__ int lds_byte(int r, int c) { const int st = (r >> 4) * 2 + (c >> 5), rr = r & 15, cc = c & 31, ob = rr * 64 + cc * 2; return st * 1024 + (ob ^ (((ob >> 9) & 1) << 5)); }
__host__ __device__ __forceinline__ void stage_rc(int b, int& R, int& C) { const int st = b / 1024, sb = b % 1024, swz = sb ^ (((sb >> 9) & 1) << 5); R = (st >> 1) * 16 + swz / 64; C = (st & 1) * 32 + (swz % 64) / 2; }
__host__ __device__ __forceinline__ int perm32(int rho) { const int n = rho >> 4, i = rho & 15; return 8 * (i >> 2) + 4 * n + (i & 3); }

struct Unit { int pm, pn, aofs, tag; };
struct Gemm { const bf16* A; const bf16* Bt; int lda, K; };

struct TileOrder {
    int nM, nN, nwg, G, c, nbr;
    __device__ void init(int M, int N, int G_, int c_, int nbr_) { nM = M / BM; nN = N / BM; nwg = nM * nN; G = G_; c = c_; nbr = nbr_; }
    __device__ bool next(int i, Unit& u) const {
        const int it = i / nbr, br = i - it * nbr;
        const long L = (long)it * G + c; if (L >= nwg) return false;
        int wgid = (int)L; { const int q = nwg / NXCD, r = nwg % NXCD, xcd = wgid % NXCD, off = wgid / NXCD; wgid = (xcd < r ? xcd * (q + 1) : r * (q + 1) + (xcd - r) * q) + off; }
        const int nig = WGM * nN, gid = wgid / nig, fm = gid * WGM, gsz = (nM - fm) < WGM ? (nM - fm) : WGM;
        u.pm = fm + ((wgid % nig) % gsz); u.pn = (wgid % nig) / gsz + br * nN; u.aofs = br * 1024; u.tag = br; return true;
    }
};

template <class Epi, int A_AUX = 0>
__device__ __forceinline__ void gemm_phase(LAS unsigned char* lds, const Gemm g, const TileOrder& S, const Epi& E, const int wid) {
    int lane = (int)__builtin_amdgcn_mbcnt_hi(~0u, __builtin_amdgcn_mbcnt_lo(~0u, 0u)); asm volatile("" : "+v"(lane));
    const int tid = wid * 64 + lane, wr = wid >> 2, wc = wid & 3, fr = lane & 15, fq = lane >> 4;
    const int K = g.K, nt = K / BK, lda = g.lda;
    unsigned voffA[2], voffB[2];
#pragma unroll
    for (int i = 0; i < 2; ++i) { int R, C; stage_rc(tid * 16 + i * 8192, R, C); const int Rb = Epi::PERM ? ((R & ~31) + perm32(R & 31)) : R;
        voffA[i] = (unsigned)(R * lda + C) * 2u; voffB[i] = (unsigned)(Rb * K + C) * 2u; }
    const size_t kstep = (size_t)(BK * 2);
    const size_t hstepA = (size_t)HALF * lda * 2, hstepB = (size_t)HALF * K * 2;
    const size_t tstepA = 2 * hstepA, tstepB = 2 * hstepB;
    const unsigned ldsw = (unsigned)wid * 1024u;
    const int aoff = lds_byte(wr * 64 + fr, fq * 8), boff = lds_byte(wc * 32 + fr, fq * 8);
#define PG8_SA(b, h) (((b) * 2 + (h)) * HTB)
#define PG8_SB(b, h) ((4 + (b) * 2 + (h)) * HTB)
#define PG8_STAGE_X(bufoff, gbase, voff, AUX) do { _Pragma("unroll") for (int _i = 0; _i < 2; ++_i) \
        __builtin_amdgcn_global_load_lds((const unsigned*)((const char*)(gbase) + (voff)[_i]), (LAS unsigned*)(lds + (bufoff) + ldsw + _i * 8192), 16, 0, AUX); } while (0)
#define PG8_STAGE(bufoff, gbase, voff) PG8_STAGE_X(bufoff, gbase, voff, 0)
#define PG8_STAGEA(bufoff, gbase, voff) PG8_STAGE_X(bufoff, gbase, voff, A_AUX)
#define PG8_LDA(dst, b, h) do { _Pragma("unroll") for (int m = 0; m < 4; ++m) _Pragma("unroll") for (int k = 0; k < 2; ++k) dst[m][k] = *(const LAS bf16x8*)(lds + PG8_SA(b, h) + aoff + m * 2048 + k * 1024); } while (0)
#define PG8_LDB(dst, b, h) do { _Pragma("unroll") for (int n = 0; n < 2; ++n) _Pragma("unroll") for (int k = 0; k < 2; ++k) dst[n][k] = *(const LAS bf16x8*)(lds + PG8_SB(b, h) + boff + n * 2048 + k * 1024); } while (0)
#define PG8_MMA(ai, bj, At, Bt) do { __builtin_amdgcn_s_setprio(1); _Pragma("unroll") for (int m = 0; m < 4; ++m) _Pragma("unroll") for (int n = 0; n < 2; ++n) _Pragma("unroll") for (int k = 0; k < 2; ++k) \
        acc[ai][bj][m][n] = __builtin_amdgcn_mfma_f32_16x16x32_bf16(Bt[n][k], At[m][k], acc[ai][bj][m][n], 0, 0, 0); __builtin_amdgcn_s_setprio(0); } while (0)
#define PG8_WAIT_V(n) asm volatile("s_waitcnt vmcnt(" #n ")" ::: "memory")
#define PG8_WAIT_L(n) asm volatile("s_waitcnt lgkmcnt(" #n ")" ::: "memory")
#define PG8_BAR __builtin_amdgcn_s_barrier()
#define PG8_SCHED __builtin_amdgcn_sched_barrier(0)
    Unit cur, nxt; int ui = 0;
    if (!S.next(0, cur)) return;
    f32x4 acc[2][2][4][2];
#pragma unroll
    for (int a = 0; a < 2; ++a)
#pragma unroll
        for (int b = 0; b < 2; ++b)
#pragma unroll
            for (int m = 0; m < 4; ++m)
#pragma unroll
                for (int n = 0; n < 2; ++n) acc[a][b][m][n] = (f32x4){0.f, 0.f, 0.f, 0.f};
    bf16x8 At[4][2], B0[2][2], B1[2][2];
    const char* cA = (const char*)g.A + (size_t)cur.pm * tstepA + cur.aofs; const char* cB = (const char*)g.Bt + (size_t)cur.pn * tstepB;
    {
        PG8_STAGE(PG8_SB(0, 0), cB, voffB); PG8_STAGE(PG8_SB(0, 1), cB + hstepB, voffB); PG8_STAGEA(PG8_SA(0, 0), cA, voffA); PG8_STAGEA(PG8_SA(0, 1), cA + hstepA, voffA);
        if (wr == 1) PG8_BAR;
        PG8_WAIT_V(2); PG8_BAR;
        PG8_STAGE(PG8_SB(1, 0), cB + kstep, voffB); PG8_STAGEA(PG8_SA(1, 0), cA + kstep, voffA); PG8_STAGE(PG8_SB(1, 1), cB + hstepB + kstep, voffB);
        PG8_WAIT_V(6); PG8_BAR;
    }
    for (;;) {
        const bool has_next = S.next(ui + 1, nxt);
        const char* nA = has_next ? (const char*)g.A + (size_t)nxt.pm * tstepA + nxt.aofs : cA; const char* nB = has_next ? (const char*)g.Bt + (size_t)nxt.pn * tstepB : cB;
        for (int t = 0; t < nt; t += 2) {
            const bool last = (t == nt - 2);
            const char* a1 = cA + (size_t)(t + 1) * kstep;
            const char* a2 = last ? nA : cA + (size_t)(t + 2) * kstep; const char* b2 = last ? nB : cB + (size_t)(t + 2) * kstep;
            const char* a3 = a2 + kstep; const char* b3 = b2 + kstep;
            PG8_LDB(B0, 0, 0); PG8_LDB(B1, 0, 1); PG8_SCHED; PG8_LDA(At, 0, 0); PG8_STAGEA(PG8_SA(1, 1), a1 + hstepA, voffA);
            PG8_WAIT_V(8); PG8_WAIT_L(0); PG8_BAR; PG8_MMA(0, 0, At, B0); PG8_MMA(0, 1, At, B1); PG8_BAR; PG8_SCHED;
            PG8_LDA(At, 0, 1); PG8_STAGE(PG8_SB(0, 0), b2, voffB); PG8_STAGE(PG8_SB(0, 1), b2 + hstepB, voffB); PG8_STAGEA(PG8_SA(0, 0), a2, voffA);
            PG8_WAIT_V(8); PG8_WAIT_L(0); PG8_BAR; PG8_MMA(1, 0, At, B0); PG8_MMA(1, 1, At, B1); PG8_BAR; PG8_SCHED;
            PG8_LDB(B0, 1, 0); PG8_LDB(B1, 1, 1); PG8_SCHED; PG8_LDA(At, 1, 0); PG8_STAGEA(PG8_SA(0, 1), a2 + hstepA, voffA);
            PG8_WAIT_V(8); PG8_WAIT_L(0); PG8_BAR; PG8_MMA(0, 0, At, B0); PG8_MMA(0, 1, At, B1); PG8_BAR; PG8_SCHED;
            PG8_LDA(At, 1, 1); PG8_STAGE(PG8_SB(1, 0), b3, voffB); PG8_STAGE(PG8_SB(1, 1), b3 + hstepB, voffB); PG8_STAGEA(PG8_SA(1, 0), a3, voffA);
            PG8_WAIT_V(8); PG8_WAIT_L(0); PG8_BAR; PG8_MMA(1, 0, At, B0); PG8_MMA(1, 1, At, B1); PG8_BAR; PG8_SCHED;
        }
        if (wr == 0) PG8_BAR;
        E(acc, cur, wr, wc, fr, fq);
        if (!has_next) break;
#pragma unroll
        for (int a = 0; a < 2; ++a)
#pragma unroll
            for (int b = 0; b < 2; ++b)
#pragma unroll
                for (int m = 0; m < 4; ++m)
#pragma unroll
                    for (int n = 0; n < 2; ++n) acc[a][b][m][n] = (f32x4){0.f, 0.f, 0.f, 0.f};
        cur = nxt; cA = nA; cB = nB; ++ui;
        if (wr == 1) PG8_BAR;
    }
    PG8_WAIT_V(0);
    PG8_BAR;
#undef PG8_SA
#undef PG8_SB
#undef PG8_STAGE
#undef PG8_STAGEA
#undef PG8_STAGE_X
#undef PG8_LDA
#undef PG8_LDB
#undef PG8_MMA
#undef PG8_WAIT_V
#undef PG8_WAIT_L
#undef PG8_BAR
#undef PG8_SCHED
}

typedef f32x4 Acc[2][2][4][2];

struct EpiSwiglu {
    static constexpr bool PERM = true; bf16* O;
    __device__ __forceinline__ void operator()(const Acc& acc, const Unit& u, int wr, int wc, int fr, int fq) const {
        const int row0 = u.pm * BM + wr * 64 + fr, col0 = u.pn * 128 + wc * 32 + 8 * fq;
#pragma unroll
        for (int ai = 0; ai < 2; ++ai)
#pragma unroll
            for (int m = 0; m < 4; ++m) {
                bf16* rowp = O + (size_t)(row0 + ai * HALF + m * 16) * DFF + col0;
                const f32x4 g0 = acc[ai][0][m][0], g1 = acc[ai][0][m][1], u0 = acc[ai][1][m][0], u1 = acc[ai][1][m][1];
                u32x4 w;
                w.x = pk2(siluf_(g0[0]) * u0[0], siluf_(g0[1]) * u0[1]); w.y = pk2(siluf_(g0[2]) * u0[2], siluf_(g0[3]) * u0[3]);
                w.z = pk2(siluf_(g1[0]) * u1[0], siluf_(g1[1]) * u1[1]); w.w = pk2(siluf_(g1[2]) * u1[2], siluf_(g1[3]) * u1[3]);
                *(u32x4*)rowp = w;
            }
    }
};
struct EpiResid {
    static constexpr bool PERM = false; const float* base; float* out; float alpha, s;
    __device__ __forceinline__ void operator()(const Acc& acc, const Unit& u, int wr, int wc, int fr, int fq) const {
        const int col0 = u.pn * BM + wc * 32 + 4 * fq;
#pragma unroll
        for (int ai = 0; ai < 2; ++ai)
#pragma unroll
            for (int m = 0; m < 4; ++m) {
                const size_t off = (size_t)(u.pm * BM + ai * HALF + wr * 64 + m * 16 + fr) * DM + col0;
#pragma unroll
                for (int bj = 0; bj < 2; ++bj)
#pragma unroll
                    for (int n = 0; n < 2; ++n) { const f32x4 b = *(const f32x4*)(base + off + bj * HALF + n * 16); *(f32x4*)(out + off + bj * HALF + n * 16) = b * alpha + acc[ai][bj][m][n] * s; }
            }
    }
};
struct EpiHm {
    static constexpr bool PERM = true; bf16* O; bf16* Vt; int ldc, vlo;
    __device__ __forceinline__ void operator()(const Acc& acc, const Unit& u, int wr, int wc, int fr, int fq) const {
        const int row0 = u.pm * BM + wr * 64 + fr;
        if (u.pn == vlo || u.pn == vlo + 1) {
#pragma unroll
            for (int ai = 0; ai < 2; ++ai)
#pragma unroll
                for (int m = 0; m < 4; ++m) {
                    const int r = row0 + ai * HALF + m * 16, bl = r >> 12, t = r & 4095;
#pragma unroll
                    for (int bj = 0; bj < 2; ++bj)
#pragma unroll
                        for (int n = 0; n < 2; ++n)
#pragma unroll
                            for (int e = 0; e < 4; ++e) {
                                const int cv = (u.pn - vlo) * 256 + bj * HALF + wc * 32 + 8 * fq + 4 * n + e;
                                Vt[((size_t)(bl * 4 + (cv >> 7)) * 128 + (cv & 127)) * SEQ + t] = (bf16)f2bf(acc[ai][bj][m][n][e]);
                            }
                }
            return;
        }
        const int col0 = u.pn * BM + wc * 32 + 8 * fq;
#pragma unroll
        for (int ai = 0; ai < 2; ++ai)
#pragma unroll
            for (int m = 0; m < 4; ++m) {
                bf16* rowp = O + (size_t)(row0 + ai * HALF + m * 16) * ldc + col0;
#pragma unroll
                for (int bj = 0; bj < 2; ++bj) { const f32x4 v0 = acc[ai][bj][m][0], v1 = acc[ai][bj][m][1]; u32x4 w; w.x = pk2(v0[0], v0[1]); w.y = pk2(v0[2], v0[3]); w.z = pk2(v1[0], v1[1]); w.w = pk2(v1[2], v1[3]); *(u32x4*)(rowp + bj * HALF) = w; }
            }
    }
};
struct EpiMerge {
    static constexpr bool PERM = true; const bf16* Hg; bf16* Mg;
    __device__ __forceinline__ void operator()(const Acc& acc, const Unit& u, int wr, int wc, int fr, int fq) const {
        const int br = u.tag, pn4 = u.pn - 4 * br;
        const int row0 = u.pm * BM + wr * 64 + fr, col0 = pn4 * BM + wc * 32 + 8 * fq;
#pragma unroll
        for (int ai = 0; ai < 2; ++ai)
#pragma unroll
            for (int m = 0; m < 4; ++m) {
                const int r = row0 + ai * HALF + m * 16;
#pragma unroll
                for (int bj = 0; bj < 2; ++bj) {
                    const unsigned long long* gq = (const unsigned long long*)(Hg + (size_t)r * HGW + br * 1024 + col0 + bj * HALF);
                    const unsigned long long g0 = __hip_atomic_load(gq, __ATOMIC_RELAXED, __HIP_MEMORY_SCOPE_AGENT), g1 = __hip_atomic_load(gq + 1, __ATOMIC_RELAXED, __HIP_MEMORY_SCOPE_AGENT);
                    u32x4 gt; gt.x = (unsigned)g0; gt.y = (unsigned)(g0 >> 32); gt.z = (unsigned)g1; gt.w = (unsigned)(g1 >> 32);
                    bf16* mp = Mg + (size_t)r * DM + col0 + bj * HALF;
                    const f32x4 v0 = acc[ai][bj][m][0], v1 = acc[ai][bj][m][1];
                    float o[8] = {sigmoidf_(bflo(gt.x)) * v0[0], sigmoidf_(bfhi(gt.x)) * v0[1], sigmoidf_(bflo(gt.y)) * v0[2], sigmoidf_(bfhi(gt.y)) * v0[3], sigmoidf_(bflo(gt.z)) * v1[0], sigmoidf_(bfhi(gt.z)) * v1[1], sigmoidf_(bflo(gt.w)) * v1[2], sigmoidf_(bfhi(gt.w)) * v1[3]};
                    if (br > 0) {
                        const unsigned long long q0 = __hip_atomic_load((const unsigned long long*)mp, __ATOMIC_RELAXED, __HIP_MEMORY_SCOPE_AGENT), q1 = __hip_atomic_load((const unsigned long long*)mp + 1, __ATOMIC_RELAXED, __HIP_MEMORY_SCOPE_AGENT);
                        u32x4 od; od.x = (unsigned)q0; od.y = (unsigned)(q0 >> 32); od.z = (unsigned)q1; od.w = (unsigned)(q1 >> 32); o[0] += bflo(od.x); o[1] += bfhi(od.x); o[2] += bflo(od.y); o[3] += bfhi(od.y); o[4] += bflo(od.z); o[5] += bfhi(od.z); o[6] += bflo(od.w); o[7] += bfhi(od.w); }
                    u32x4 w; w.x = pk2(o[0], o[1]); w.y = pk2(o[2], o[3]); w.z = pk2(o[4], o[5]); w.w = pk2(o[6], o[7]); *(u32x4*)mp = w;
                }
            }
    }
};
}

struct Params { const float* in[34]; float* out; unsigned char* ws; int ph_lo, ph_hi; };

struct Ctx {
    LAS unsigned char* lds; int G, bid, wv;
    float* X; unsigned char* ws;
};
#define c_W   ((bf16*)(c.ws + WS_W))
#define c_XN  ((bf16*)(c.ws + WS_XN))
#define c_HB  ((bf16*)(c.ws + WS_A))
#define c_Hm  ((bf16*)(c.ws + WS_A))
#define c_Mg  ((bf16*)(c.ws + WS_A))
#define c_P6  ((bf16*)(c.ws + WS_P6))
#define c_GQK ((bf16*)(c.ws + WS_GQK))
#define c_GV  ((bf16*)(c.ws + WS_GV))
#define c_Vt  ((bf16*)(c.ws + WS_VT))
#define c_Hg  ((bf16*)(c.ws + WS_P6))
#define c_Y   ((bf16*)(c.ws + WS_C))
#define c_BON ((float*)(c.ws + WS_BON))
#define c_GB  ((float*)(c.ws + WS_GB))
__device__ __forceinline__ const float* in_ptr(int i) {
    const char __attribute__((address_space(4)))* ka = (const char __attribute__((address_space(4)))*)__builtin_amdgcn_kernarg_segment_ptr();
    asm volatile("" : "+s"(ka));
    return *(const float* const __attribute__((address_space(4)))*)(ka + 8 * i);
}
#define PHASE_IDS() const int wave = c.wv; int lane = (int)__builtin_amdgcn_mbcnt_hi(~0u, __builtin_amdgcn_mbcnt_lo(~0u, 0u)); asm volatile("" : "+v"(lane)); const int tid = wave * 64 + lane; (void)tid

template <int MODE> __device__ __forceinline__ int wrow_map(int j) {
    if (MODE == 1) { const int up = j >= DFF, i = up ? j - DFF : j; return (i >> 7) * 256 + up * 128 + (i & 127); }
    if (MODE == 2) return j < 5384 ? j : 5632 + (j - 5384);
    return j;
}
template <int MODE> __device__ __forceinline__ void transpose_item(const float* W, int K, int N, bf16* WT, int row_off, LAS float* scr, int item, int lane) {
    const int nblk = (N + 31) / 32, kb = item / nblk, nb = item % nblk, k0 = 64 * kb, n0 = 32 * nb;
    const int colr = n0 + (lane & 31);
    float tv[32];
#pragma unroll
    for (int i = 0; i < 32; ++i) { const int kk = 2 * i + (lane >> 5); tv[i] = colr < N ? W[(size_t)(k0 + kk) * N + colr] : 0.f; }
#pragma unroll
    for (int i = 0; i < 32; ++i) { const int kk = 2 * i + (lane >> 5); scr[kk * 33 + (lane & 31)] = tv[i]; }
    asm volatile("s_waitcnt lgkmcnt(0)" ::: "memory");
    const int c = lane & 7;
#pragma unroll
    for (int j = 0; j < 4; ++j) { const int n = (lane >> 3) + 8 * j; const LAS float* s = scr + (8 * c) * 33 + n;
        u32x4 o; o.x = pk2(s[0 * 33], s[1 * 33]); o.y = pk2(s[2 * 33], s[3 * 33]); o.z = pk2(s[4 * 33], s[5 * 33]); o.w = pk2(s[6 * 33], s[7 * 33]);
        if (n0 + n < N) *(u32x4*)(WT + (size_t)(row_off + wrow_map<MODE>(n0 + n)) * K + k0 + 8 * c) = o; }
    asm volatile("s_waitcnt lgkmcnt(0)" ::: "memory");
}
__device__ __forceinline__ void ph_weights(const Ctx& c, int l) {
    PHASE_IDS();
    LAS float* scr = (LAS float*)(c.lds + wave * 16384);
    const int gw = c.bid * NWAVES + wave, NGW = c.G * NWAVES;
    constexpr int I1 = 16 * 176, I2 = 44 * 32, I3 = 16 * 265, I4 = 8 * 32, I5 = 16 * 32;
    constexpr int NIT = I1 + I2 + I3 + 3 * I4 + I5 + I1 + I2;
    const float* w1 = in_ptr(1) + (size_t)l * DM * 2 * DFF; const float* w2 = in_ptr(2) + (size_t)l * DFF * DM;
    const float* wm = in_ptr(5) + (size_t)l * DM * 8456; const float* wb = in_ptr(26) + (size_t)l * 3 * 512 * DM; const float* wo = in_ptr(27) + (size_t)l * DM * DM;
    const float* w3 = in_ptr(30) + (size_t)l * DM * 2 * DFF; const float* w4 = in_ptr(31) + (size_t)l * DFF * DM;
    for (int it = gw; it < NIT; it += NGW) {
        int r = it;
        if (r < I1) { transpose_item<1>(w1, DM, 2 * DFF, c_W + W_1, 0, scr, r, lane); continue; } r -= I1;
        if (r < I2) { transpose_item<0>(w2, DFF, DM, c_W + W_2, 0, scr, r, lane); continue; } r -= I2;
        if (r < I3) { transpose_item<2>(wm, DM, 8456, c_W + W_M, 0, scr, r, lane); continue; } r -= I3;
        if (r < 3 * I4) { const int br = r / I4; transpose_item<0>(wb + (size_t)br * 512 * DM, 512, DM, c_W + W_B, br * 1024, scr, r - br * I4, lane); continue; } r -= 3 * I4;
        if (r < I5) { transpose_item<0>(wo, DM, DM, c_W + W_O, 0, scr, r, lane); continue; } r -= I5;
        if (r < I1) { transpose_item<1>(w3, DM, 2 * DFF, c_W + W_3, 0, scr, r, lane); continue; } r -= I1;
        transpose_item<0>(w4, DFF, DM, c_W + W_4, 0, scr, r, lane);
    }
}

__device__ __forceinline__ void ph_ln(const Ctx& c, const float* g, const float* b) {
    PHASE_IDS();
    const int gw = c.bid * NWAVES + wave, NGW = c.G * NWAVES;
    f32x4 gv[4], bv[4];
#pragma unroll
    for (int j = 0; j < 4; ++j) { gv[j] = *((const f32x4*)g + lane + 64 * j); bv[j] = *((const f32x4*)b + lane + 64 * j); }
    for (int m0 = gw; m0 < MTOK; m0 += 8 * NGW) {
        f32x4 v[8][4];
#pragma unroll
        for (int r = 0; r < 8; ++r) { const int mr = (m0 + r * NGW) < MTOK ? (m0 + r * NGW) : m0; const f32x4* xr = (const f32x4*)(c.X + (size_t)mr * DM) + lane;
#pragma unroll
            for (int j = 0; j < 4; ++j) v[r][j] = xr[64 * j]; }
#pragma unroll
        for (int r = 0; r < 8; ++r) {
            const int m = m0 + r * NGW; if (m >= MTOK) break;
            f32x4* xr = (f32x4*)(c.X + (size_t)m * DM) + lane;
            float s = 0.f;
#pragma unroll
            for (int j = 0; j < 4; ++j) s += (v[r][j].x + v[r][j].y) + (v[r][j].z + v[r][j].w);
            const float mean = wave_sum(s) * (1.f / DM); float s2 = 0.f;
#pragma unroll
            for (int j = 0; j < 4; ++j) { v[r][j] = v[r][j] - mean; s2 += (v[r][j].x * v[r][j].x + v[r][j].y * v[r][j].y) + (v[r][j].z * v[r][j].z + v[r][j].w * v[r][j].w); }
            const float rstd = __builtin_amdgcn_rsqf(wave_sum(s2) * (1.f / DM) + 1e-5f);
            u32x2* o8 = (u32x2*)(c_XN + (size_t)m * DM) + lane;
#pragma unroll
            for (int j = 0; j < 4; ++j) { const f32x4 y = v[r][j] * rstd * gv[j] + bv[j]; xr[64 * j] = y; u32x2 w; w.x = pk2(y.x, y.y); w.y = pk2(y.z, y.w); o8[64 * j] = w; }
        }
    }
}
__device__ __forceinline__ void ph_x_to_bf16(const Ctx& c) {
    PHASE_IDS();
    const int gw = c.bid * NWAVES + wave, NGW = c.G * NWAVES;
    const float* xin = in_ptr(0);
    for (int m0 = gw; m0 < MTOK; m0 += 4 * NGW) {
        f32x4 y[4][4];
#pragma unroll
        for (int r = 0; r < 4; ++r) { const int mr = (m0 + r * NGW) < MTOK ? (m0 + r * NGW) : m0; const f32x4* xr = (const f32x4*)(xin + (size_t)mr * DM) + lane;
#pragma unroll
            for (int j = 0; j < 4; ++j) y[r][j] = xr[64 * j]; }
#pragma unroll
        for (int r = 0; r < 4; ++r) { const int m = m0 + r * NGW; if (m >= MTOK) break; u32x2* o8 = (u32x2*)(c_XN + (size_t)m * DM) + lane;
#pragma unroll
            for (int j = 0; j < 4; ++j) { u32x2 w; w.x = pk2(y[r][j].x, y[r][j].y); w.y = pk2(y[r][j].z, y[r][j].w); o8[64 * j] = w; } }
    }
}

__device__ __forceinline__ void ph_prep(const Ctx& c, int l) {
    LAS bf16* ACT = (LAS bf16*)c.lds;
    const float* mu = in_ptr(6) + l * 1792; const float* w0 = in_ptr(7) + l * 512; const float* wup = in_ptr(8) + l * 64 * 512;
    const float* a0 = in_ptr(9) + l * 512; const float* aup = in_ptr(10) + l * 64 * 512;
    const float* kkw = in_ptr(12) + l * 512; const float* kaw = in_ptr(13) + l * 512; const float* rkw = in_ptr(14) + l * 512;
    const float* convw = in_ptr(22) + l * 4 * 1536; const float* alog = in_ptr(23) + l * 4; const float* dtb = in_ptr(24) + l * 4;
    PHASE_IDS(); const bf16* Hm = c_Hm; const int h = wave;
    LAS bf16* RES = (LAS bf16*)(c.lds + 16384) + wave * 4096;
    const int mi = lane & 15, g4 = lane >> 4;
    bf16x8 wb[2][4][2];
#pragma unroll
    for (int mv = 0; mv < 2; ++mv)
#pragma unroll
        for (int nt = 0; nt < 4; ++nt)
#pragma unroll
            for (int ks = 0; ks < 2; ++ks) { const float* W = (mv ? aup : wup) + (size_t)(32 * ks + 8 * g4) * 512 + h * 64 + nt * 16 + mi;
                u32x4 pw; pw.x = pk2(W[0], W[512]); pw.y = pk2(W[1024], W[1536]); pw.z = pk2(W[2048], W[2560]); pw.w = pk2(W[3072], W[3584]); wb[mv][nt][ks] = __builtin_bit_cast(bf16x8, pw); }
    for (int tile = c.bid; tile < MH / 32; tile += c.G) {
        const int R0 = tile * 32, t0 = R0 & (SEQ - 1);
        __syncthreads();
#pragma unroll
        for (int e = tid; e < 32 * 128; e += 512) { const int tt = e >> 7, j = e & 127, col = 1536 + j, R = R0 + tt; const float z = bf2f(Hm[(size_t)R * HMW + col]);
            const float pv = (t0 + tt) > 0 ? bf2f(Hm[(size_t)(R - 1) * HMW + col]) : 0.f; const float s = z + mu[col] * (pv - z);
            ACT[((j < 64 ? 0 : 32) + tt) * 72 + (j & 63)] = (bf16)f2bf(j < 64 ? tanhf_(s) : s); }
        __syncthreads();
#pragma unroll
        for (int mv = 0; mv < 2; ++mv)
#pragma unroll
            for (int mt = 0; mt < 2; ++mt) {
                const bf16x8 af0 = *(const LAS bf16x8*)(ACT + (mv * 32 + mt * 16 + mi) * 72 + 8 * g4), af1 = *(const LAS bf16x8*)(ACT + (mv * 32 + mt * 16 + mi) * 72 + 32 + 8 * g4);
#pragma unroll
                for (int nt = 0; nt < 4; ++nt) {
                    f32x4 d = __builtin_amdgcn_mfma_f32_16x16x32_bf16(af0, wb[mv][nt][0], (f32x4){0.f, 0.f, 0.f, 0.f}, 0, 0, 0);
                    d = __builtin_amdgcn_mfma_f32_16x16x32_bf16(af1, wb[mv][nt][1], d, 0, 0, 0);
#pragma unroll
                    for (int i = 0; i < 4; ++i) RES[(mv * 32 + mt * 16 + 4 * g4 + i) * 64 + nt * 16 + mi] = (bf16)f2bf(d[i]);
                }
            }
        {
            const float bias = w0[tid];
#pragma unroll 1
            for (int tt = 0; tt < 32; ++tt) {
                const float acc = bias + bf2f(RES[tt * 64 + lane]);
                const float w = __expf(-0.6065306597126334f * sigmoidf_(acc));
                c_P6[((size_t)(R0 + tt) * 8 + h) * 384 + 64 + lane] = (bf16)f2bf(w);
            }
        }
        {
            const float bias = a0[tid], mur = mu[tid], muk = mu[512 + tid], muv = mu[1024 + tid], kk_ = kkw[tid], ka_ = kaw[tid], rk_ = rkw[tid];
            float pr = 0.f, pk = 0.f, pvv = 0.f;
            if (t0 > 0) { const bf16* hp = Hm + (size_t)(R0 - 1) * HMW; pr = bf2f(hp[tid]); pk = bf2f(hp[512 + tid]); pvv = bf2f(hp[1024 + tid]); }
#pragma unroll 1
            for (int tg = 0; tg < 4; ++tg) {
                bf16 zr8[8], zk8[8], zv8[8];
#pragma unroll
                for (int u = 0; u < 8; ++u) { const bf16* hp = Hm + (size_t)(R0 + tg * 8 + u) * HMW; zr8[u] = hp[tid]; zk8[u] = hp[512 + tid]; zv8[u] = hp[1024 + tid]; }
#pragma unroll
                for (int u = 0; u < 8; ++u) {
                    const int tt = tg * 8 + u;
                    const float a = sigmoidf_(bias + bf2f(RES[(32 + tt) * 64 + lane]));
                    const float zr = bf2f(zr8[u]), zk = bf2f(zk8[u]), zv = bf2f(zv8[u]);
                    const float r = zr + mur * (pr - zr), k = zk + muk * (pk - zk), v = zv + muv * (pvv - zv);
                    pr = zr; pk = zk; pvv = zv;
                    const float kx = k * kk_; const float ss = wave_sum(kx * kx); const float kk = kx * __builtin_amdgcn_rsqf(ss + 1e-6f);
                    const float kt = k * (1.0f + (a - 1.0f) * ka_);
                    const float bn = wave_sum(r * kt * rk_);
                    bf16* q = c_P6 + ((size_t)(R0 + tt) * 8 + h) * 384 + lane;
                    q[0] = (bf16)f2bf(r); q[128] = (bf16)f2bf(kt); q[192] = (bf16)f2bf(v); q[256] = (bf16)f2bf(kk); q[320] = (bf16)f2bf(kk * a);
                    if (lane == 0) c_BON[(size_t)(R0 + tt) * 8 + h] = bn;
                }
            }
        }
        for (int tk = wave; tk < 24; tk += 8) {
            const int kh = tk % 12, th = tk / 12, kind = kh >> 2, head = kh & 3, ch = kind * 512 + head * 128 + 2 * lane;
            float cw[4][2];
#pragma unroll
            for (int j = 0; j < 4; ++j) { cw[j][0] = convw[j * 1536 + ch]; cw[j][1] = convw[j * 1536 + ch + 1]; }
            const int Rs = R0 + 16 * th, ts = t0 + 16 * th;
            float x[3][2];
#pragma unroll
            for (int k = 0; k < 3; ++k) { x[k][0] = 0.f; x[k][1] = 0.f; if (ts - 3 + k >= 0) { const unsigned u = *(const unsigned*)(Hm + (size_t)(Rs - 3 + k) * HMW + C_GD + ch); x[k][0] = bflo(u); x[k][1] = bfhi(u); } }
            unsigned uu[16];
#pragma unroll
            for (int i = 0; i < 16; ++i) uu[i] = *(const unsigned*)(Hm + (size_t)(Rs + i) * HMW + C_GD + ch);
#pragma unroll
            for (int i = 0; i < 16; ++i) {
                const float z0 = bflo(uu[i]), z1 = bfhi(uu[i]);
                float y0 = cw[0][0] * x[0][0] + cw[1][0] * x[1][0] + cw[2][0] * x[2][0] + cw[3][0] * z0;
                float y1 = cw[0][1] * x[0][1] + cw[1][1] * x[1][1] + cw[2][1] * x[2][1] + cw[3][1] * z1;
                x[0][0] = x[1][0]; x[0][1] = x[1][1]; x[1][0] = x[2][0]; x[1][1] = x[2][1]; x[2][0] = z0; x[2][1] = z1;
                y0 = siluf_(y0); y1 = siluf_(y1);
                if (kind < 2) { const float ss = wave_sum(y0 * y0 + y1 * y1); float sc = __builtin_amdgcn_rsqf(ss + 1e-6f); if (kind == 0) sc *= 0.08838834764831845f; y0 *= sc; y1 *= sc;
                    *(unsigned*)(c_GQK + ((size_t)(Rs + i) * 4 + head) * 256 + kind * 128 + 2 * lane) = pk2(y0, y1); }
                else *(unsigned*)(c_GV + (size_t)(Rs + i) * 512 + head * 128 + 2 * lane) = pk2(y0, y1);
            }
        }
        if (tid < 128) { const int tt = tid >> 2, hh = tid & 3; const size_t R = R0 + tt; const float alg = bf2f(Hm[R * HMW + C_GDA + hh]), blg = bf2f(Hm[R * HMW + C_GDB + hh]);
            const float xs = alg + dtb[hh]; const float sp = xs > 20.f ? xs : log1pf(__expf(xs));
            c_GB[(R * 4 + hh) * 2] = __expf(-__expf(alog[hh]) * sp); c_GB[(R * 4 + hh) * 2 + 1] = sigmoidf_(blg); }
    }
}

__device__ __forceinline__ void rwkv_scan(const Ctx& c, int task, int lane, LAS unsigned char* wl) {
    const int rg = lane >> 4, sub = lane & 15;
    const int bh = task >> 4, row = (task & 15) * 4 + rg, bl = bh >> 3, h = bh & 7;
    const unsigned char* gsrc = (const unsigned char*)(c_P6 + ((size_t)bl * SEQ * 8 + h) * 384) + lane * 16;
    bf16* yo = c_Y + (size_t)bl * SEQ * YW + h * 64 + row;
    f32x2 sA = {0.f, 0.f}, sB = {0.f, 0.f};
    u32x4 st[16];
    const bool ld = lane < 48;
    if (ld) {
#pragma unroll
        for (int i = 0; i < 16; ++i) st[i] = *(const u32x4*)(gsrc + (size_t)i * 6144);
#pragma unroll
        for (int i = 0; i < 16; ++i) *(LAS u32x4*)(wl + lane * 16 + i * 768) = st[i];
    }
#pragma unroll 1
    for (int ch = 0; ch < SEQ / 16; ++ch) {
        const int t0 = ch * 16; const bool more = ch + 1 < SEQ / 16;
        LAS unsigned char* rb = wl + (ch & 1) * 12288;
        float yb[16];
        if (ld && more) {
#pragma unroll
            for (int i = 0; i < 16; ++i) st[i] = *(const u32x4*)(gsrc + (size_t)(t0 + 16 + i) * 6144);
        }
        u32x2 nr = *(const LAS u32x2*)(rb + sub * 8), nw = *(const LAS u32x2*)(rb + 128 + sub * 8), nk = *(const LAS u32x2*)(rb + 256 + sub * 8);
        u32x2 nkk = *(const LAS u32x2*)(rb + 512 + sub * 8), nka = *(const LAS u32x2*)(rb + 640 + sub * 8);
        bf16 nv = *(const LAS bf16*)(rb + 384 + row * 2);
        float pyv = 0.f;
#pragma unroll
        for (int i = 0; i < 16; ++i) {
            const u32x2 dr = nr, dw = nw, dk = nk, dkk = nkk, dka = nka; const float v = bf2f(nv);
            if (i + 1 < 16) { LAS unsigned char* q = rb + (i + 1) * 768;
                nr = *(const LAS u32x2*)(q + sub * 8); nw = *(const LAS u32x2*)(q + 128 + sub * 8); nk = *(const LAS u32x2*)(q + 256 + sub * 8);
                nkk = *(const LAS u32x2*)(q + 512 + sub * 8); nka = *(const LAS u32x2*)(q + 640 + sub * 8); nv = *(const LAS bf16*)(q + 384 + row * 2); }
            const f32x2 kk01 = {bflo(dkk.x), bfhi(dkk.x)}, kk23 = {bflo(dkk.y), bfhi(dkk.y)}, w01 = {bflo(dw.x), bfhi(dw.x)}, w23 = {bflo(dw.y), bfhi(dw.y)};
            const f32x2 k01 = {bflo(dk.x), bfhi(dk.x)}, k23 = {bflo(dk.y), bfhi(dk.y)}, ka01 = {bflo(dka.x), bfhi(dka.x)}, ka23 = {bflo(dka.y), bfhi(dka.y)};
            const f32x2 r01 = {bflo(dr.x), bfhi(dr.x)}, r23 = {bflo(dr.y), bfhi(dr.y)};
            const f32x2 p = sA * kk01 + sB * kk23;
            float sk = p.x + p.y, yprev = pyv;
            row_sum16x2(sk, yprev);
            if (i > 0) yb[i - 1] = yprev;
            sA = sA * w01 + (k01 * v - ka01 * sk);
            sB = sB * w23 + (k23 * v - ka23 * sk);
            const f32x2 py = sA * r01 + sB * r23;
            pyv = py.x + py.y;
        }
        yb[15] = row_sum16(pyv);
        if (sub == 0) {
#pragma unroll
            for (int i = 0; i < 16; ++i) yo[(size_t)(t0 + i) * YW] = (bf16)f2bf(yb[i]);
        }
        if (ld && more) {
            LAS unsigned char* wb = wl + ((ch + 1) & 1) * 12288 + lane * 16;
#pragma unroll
            for (int i = 0; i < 16; ++i) *(LAS u32x4*)(wb + i * 768) = st[i];
        }
    }
}
__device__ __forceinline__ void gdn_scan(const Ctx& c, int task, int lane, LAS unsigned char* wl) {
    const int rg = lane >> 4, sub = lane & 15;
    const int bh = task >> 5, cg4 = (task & 31) * 4, col = cg4 + rg, bl = bh >> 2, h = bh & 3;
    const unsigned char* gqk = (const unsigned char*)(c_GQK + ((size_t)bl * SEQ * 4 + h) * 256) + lane * 16;
    const unsigned char* gvb = lane < 16 ? (const unsigned char*)(c_GV + ((size_t)bl * SEQ + lane) * 512 + h * 128 + cg4)
                                         : (const unsigned char*)(c_GB + (((size_t)bl * SEQ + (lane - 16)) * 4 + h) * 2);
    const size_t vstep = lane < 16 ? 1024 : 32;
    bf16* yo = c_Y + (size_t)bl * SEQ * YW + 1024 + h * 128 + col;
    f32x2 g0 = {0.f, 0.f}, g1 = {0.f, 0.f}, g2 = {0.f, 0.f}, g3 = {0.f, 0.f};
    u32x4 st[16]; u32x2 sv;
    const bool ld = lane < 32;
    constexpr int BUF = 8192 + 256;
    if (ld) {
#pragma unroll
        for (int i = 0; i < 16; ++i) st[i] = *(const u32x4*)(gqk + (size_t)i * 2048);
        sv = *(const u32x2*)gvb;
#pragma unroll
        for (int i = 0; i < 16; ++i) *(LAS u32x4*)(wl + lane * 16 + i * 512) = st[i];
        *(LAS u32x2*)(wl + 8192 + lane * 8) = sv;
    }
#pragma unroll 1
    for (int ch = 0; ch < SEQ / 16; ++ch) {
        const int t0 = ch * 16; const bool more = ch + 1 < SEQ / 16;
        LAS unsigned char* rb = wl + (ch & 1) * BUF;
        float yb[16];
        if (ld && more) {
#pragma unroll
            for (int i = 0; i < 16; ++i) st[i] = *(const u32x4*)(gqk + (size_t)(t0 + 16 + i) * 2048);
            sv = *(const u32x2*)(gvb + (size_t)(t0 + 16) * vstep);
        }
        u32x4 nq = *(const LAS u32x4*)(rb + sub * 16), nk = *(const LAS u32x4*)(rb + 256 + sub * 16);
        bf16 nv = *(const LAS bf16*)(rb + 8192 + rg * 2); f32x2 ngb = *(const LAS f32x2*)(rb + 8192 + 128);
        float pov = 0.f;
#pragma unroll
        for (int i = 0; i < 16; ++i) {
            const u32x4 dq = nq, dk = nk; const float v = bf2f(nv); const f32x2 gb = ngb;
            if (i + 1 < 16) { nq = *(const LAS u32x4*)(rb + (i + 1) * 512 + sub * 16); nk = *(const LAS u32x4*)(rb + (i + 1) * 512 + 256 + sub * 16);
                nv = *(const LAS bf16*)(rb + 8192 + (i + 1) * 8 + rg * 2); ngb = *(const LAS f32x2*)(rb + 8192 + 128 + (i + 1) * 8); }
            const f32x2 k01 = {bflo(dk.x), bfhi(dk.x)}, k23 = {bflo(dk.y), bfhi(dk.y)}, k45 = {bflo(dk.z), bfhi(dk.z)}, k67 = {bflo(dk.w), bfhi(dk.w)};
            const f32x2 q01 = {bflo(dq.x), bfhi(dq.x)}, q23 = {bflo(dq.y), bfhi(dq.y)}, q45 = {bflo(dq.z), bfhi(dq.z)}, q67 = {bflo(dq.w), bfhi(dq.w)};
            const float eg = gb.x, beta = gb.y;
            const f32x2 p = (g0 * k01 + g1 * k23) + (g2 * k45 + g3 * k67);
            float ks = p.x + p.y, oprev = pov;
            row_sum16x2(ks, oprev);
            if (i > 0) yb[i - 1] = oprev;
            const float u = beta * (v - eg * ks);
            g0 = g0 * eg + k01 * u; g1 = g1 * eg + k23 * u; g2 = g2 * eg + k45 * u; g3 = g3 * eg + k67 * u;
            const f32x2 po = (g0 * q01 + g1 * q23) + (g2 * q45 + g3 * q67);
            pov = po.x + po.y;
        }
        yb[15] = row_sum16(pov);
        if (sub == 0) {
#pragma unroll
            for (int i = 0; i < 16; ++i) yo[(size_t)(t0 + i) * YW] = (bf16)f2bf(yb[i]);
        }
        if (ld && more) {
            LAS unsigned char* wb = wl + ((ch + 1) & 1) * BUF;
#pragma unroll
            for (int i = 0; i < 16; ++i) *(LAS u32x4*)(wb + lane * 16 + i * 512) = st[i];
            *(LAS u32x2*)(wb + 8192 + lane * 8) = sv;
        }
    }
}
__device__ __forceinline__ void attn_tile(const Ctx& c, int lane, int bh, int qt, float lam, float lam_init, const float* ng) {
    const int qi = lane & 15, g = lane >> 4;
    const int bl = bh >> 2, h = bh & 3, q0 = qt * 16;
    const bf16* Hb = c_Hm + (size_t)bl * SEQ * HMW;
    bf16x8 qf[2][2];
#pragma unroll
    for (int m = 0; m < 2; ++m)
#pragma unroll
        for (int s = 0; s < 2; ++s) qf[m][s] = *(const bf16x8*)(Hb + (size_t)(q0 + qi) * HMW + C_DA + h * 128 + m * 64 + s * 32 + g * 8);
    const bf16* Kb = Hb + C_DAK + h * 128 + g * 8;
    const bf16* Vb = c_Vt + ((size_t)(bl * 4 + h) * 128 + qi) * SEQ + 8 * g;
    const int krow = 8 * (qi >> 2) + (qi & 3);
    f32x4 O[2][8];
#pragma unroll
    for (int m = 0; m < 2; ++m)
#pragma unroll
        for (int d = 0; d < 8; ++d) O[m][d] = (f32x4){0.f, 0.f, 0.f, 0.f};
    float Mx[2] = {-1e30f, -1e30f}, L[2] = {0.f, 0.f};
    const float c1 = 0.125f * 1.4426950408889634f;
    const float c2 = exp2f(-2.0f * (float)(h + 1)) * 1.4426950408889634f;
    const int nb = qt / 2 + 1;
    for (int blk = nb - 1; blk >= 0; --blk) {
        const int kb = blk * 32;
        bf16x8 kf[2][2][2], vf[8];
#pragma unroll
        for (int m = 0; m < 2; ++m)
#pragma unroll
            for (int ta = 0; ta < 2; ++ta)
#pragma unroll
                for (int s = 0; s < 2; ++s) kf[m][ta][s] = *(const bf16x8*)(Kb + (size_t)(kb + krow + 4 * ta) * HMW + m * 64 + s * 32);
#pragma unroll
        for (int d = 0; d < 8; ++d) vf[d] = *(const bf16x8*)(Vb + (size_t)d * 16 * SEQ + kb);
        const int base = kb + 8 * g - (q0 + qi);
        const float fb = c2 * (float)base;
        bf16x8 pf[2];
#pragma unroll
        for (int m = 0; m < 2; ++m) {
            f32x4 S[2];
#pragma unroll
            for (int ta = 0; ta < 2; ++ta) { S[ta] = __builtin_amdgcn_mfma_f32_16x16x32_bf16(kf[m][ta][0], qf[m][0], (f32x4){0.f, 0.f, 0.f, 0.f}, 0, 0, 0); S[ta] = __builtin_amdgcn_mfma_f32_16x16x32_bf16(kf[m][ta][1], qf[m][1], S[ta], 0, 0, 0); }
            float x[8]; float mx = -1e30f;
#pragma unroll
            for (int ta = 0; ta < 2; ++ta)
#pragma unroll
                for (int i = 0; i < 4; ++i) { const int dd = base + 4 * ta + i; float v = S[ta][i] * c1 + (fb + c2 * (float)(4 * ta + i)); v = dd > 0 ? -1e30f : v; x[ta * 4 + i] = v; mx = fmaxf(mx, v); }
            mx = fmaxf(mx, __shfl_xor(mx, 16)); mx = fmaxf(mx, __shfl_xor(mx, 32));
            const float mn = fmaxf(Mx[m], mx), al = __builtin_amdgcn_exp2f(Mx[m] - mn);
            float rs = 0.f;
#pragma unroll
            for (int j = 0; j < 8; ++j) { x[j] = __builtin_amdgcn_exp2f(x[j] - mn); rs += x[j]; }
            if (__builtin_amdgcn_ballot_w64(mn != Mx[m]) != 0ull) {
                L[m] = L[m] * al; Mx[m] = mn;
#pragma unroll
                for (int d = 0; d < 8; ++d) O[m][d] = O[m][d] * al;
            }
            L[m] += rs;
            u32x4 pw; pw.x = pk2(x[0], x[1]); pw.y = pk2(x[2], x[3]); pw.z = pk2(x[4], x[5]); pw.w = pk2(x[6], x[7]);
            pf[m] = __builtin_bit_cast(bf16x8, pw);
        }
#pragma unroll
        for (int d = 0; d < 8; ++d) { O[0][d] = __builtin_amdgcn_mfma_f32_16x16x32_bf16(vf[d], pf[0], O[0][d], 0, 0, 0); O[1][d] = __builtin_amdgcn_mfma_f32_16x16x32_bf16(vf[d], pf[1], O[1][d], 0, 0, 0); }
    }
    float l0 = L[0]; l0 += __shfl_xor(l0, 16); l0 += __shfl_xor(l0, 32);
    float l1 = L[1]; l1 += __shfl_xor(l1, 16); l1 += __shfl_xor(l1, 32);
    const float i0 = 1.0f / l0, i1 = lam / l1;
    float ss = 0.f;
#pragma unroll
    for (int d = 0; d < 8; ++d) { O[0][d] = O[0][d] * i0 - O[1][d] * i1; ss += (O[0][d][0] * O[0][d][0] + O[0][d][1] * O[0][d][1]) + (O[0][d][2] * O[0][d][2] + O[0][d][3] * O[0][d][3]); }
    ss += __shfl_xor(ss, 16); ss += __shfl_xor(ss, 32);
    const float sc = __builtin_amdgcn_rsqf(ss * (1.0f / 128.0f) + 1e-5f) * (1.0f - lam_init);
    bf16* yo = c_Y + (size_t)(bl * SEQ + q0 + qi) * YW + 512 + h * 128 + 4 * g;
#pragma unroll
    for (int d = 0; d < 8; ++d) { const f32x4 gg = *(const f32x4*)(ng + 16 * d + 4 * g); const f32x4 o = O[0][d] * sc * gg; u32x2 w; w.x = pk2(o[0], o[1]); w.y = pk2(o[2], o[3]); *(u32x2*)(yo + 16 * d) = w; }
}
__device__ __forceinline__ void ph_mix(const Ctx& c, int l, int roles) {
    PHASE_IDS();
    if (wave < 2) {
        if (!(roles & 1)) return;
#if !SKIP_RW
        __builtin_amdgcn_s_setprio(1);
        for (int task = c.bid * 2 + wave; task < 512; task += c.G * 2) rwkv_scan(c, task, lane, c.lds + wave * 24576);
        __builtin_amdgcn_s_setprio(0);
#endif
    } else if (wave < 4) {
        if (!(roles & 2)) return;
#if !SKIP_GD
        __builtin_amdgcn_s_setprio(3);
        for (int task = c.bid * 2 + (wave - 2); task < 512; task += c.G * 2) gdn_scan(c, task, lane, c.lds + wave * 24576);
        __builtin_amdgcn_s_setprio(0);
#endif
    } else {
        if (!(roles & 4)) return;
#if !SKIP_DA
        const float lam_init = 0.8f - 0.6f * __expf(-0.3f * (float)l);
        const float d1 = wave_sum(in_ptr(17)[l * 64 + lane] * in_ptr(18)[l * 64 + lane]), d2 = wave_sum(in_ptr(19)[l * 64 + lane] * in_ptr(20)[l * 64 + lane]);
        const float lam = __expf(d1) - __expf(d2) + lam_init;
        const float* ng = in_ptr(21) + l * 128;
        if (wave >= 6) return;
        for (int p = c.bid * 2 + (wave - 4); p < 2048; p += c.G * 2) { const int bh = p >> 7, j = p & 127; attn_tile(c, lane, bh, 255 - j, lam, lam_init, ng); attn_tile(c, lane, bh, j, lam, lam_init, ng); }
#endif
    }
}

__device__ __forceinline__ void ph_post(const Ctx& c, int l) {
    LAS bf16* ACT = (LAS bf16*)c.lds;
    const float* mu = in_ptr(6) + l * 1792; const float* gup = in_ptr(11) + l * 128 * 512;
    const float* lng = in_ptr(15) + l * 512; const float* lnb = in_ptr(16) + l * 512; const float* gng = in_ptr(25) + l * 128;
    PHASE_IDS(); const bf16* Hm = c_Hm; const int h = wave;
    LAS bf16* RES = (LAS bf16*)(c.lds + 16384) + wave * 2048;
    const int mi = lane & 15, g4 = lane >> 4;
    bf16x8 wb[4][4];
#pragma unroll
    for (int nt = 0; nt < 4; ++nt)
#pragma unroll
        for (int ks = 0; ks < 4; ++ks) { const float* W = gup + (size_t)(32 * ks + 8 * g4) * 512 + h * 64 + nt * 16 + mi;
            u32x4 pw; pw.x = pk2(W[0], W[512]); pw.y = pk2(W[1024], W[1536]); pw.z = pk2(W[2048], W[2560]); pw.w = pk2(W[3072], W[3584]); wb[nt][ks] = __builtin_bit_cast(bf16x8, pw); }
    for (int tile = c.bid; tile < MH / 32; tile += c.G) {
        const int R0 = tile * 32, t0 = R0 & (SEQ - 1);
        __syncthreads();
#pragma unroll
        for (int e = tid; e < 32 * 128; e += 512) { const int tt = e >> 7, j = e & 127, col = 1664 + j, R = R0 + tt; const float z = bf2f(Hm[(size_t)R * HMW + col]);
            const float pv = (t0 + tt) > 0 ? bf2f(Hm[(size_t)(R - 1) * HMW + col]) : 0.f; ACT[tt * 136 + j] = (bf16)f2bf(sigmoidf_(z + mu[col] * (pv - z))); }
        __syncthreads();
#pragma unroll
        for (int mt = 0; mt < 2; ++mt) {
            bf16x8 af[4];
#pragma unroll
            for (int ks = 0; ks < 4; ++ks) af[ks] = *(const LAS bf16x8*)(ACT + (mt * 16 + mi) * 136 + 32 * ks + 8 * g4);
#pragma unroll
            for (int nt = 0; nt < 4; ++nt) {
                f32x4 d = (f32x4){0.f, 0.f, 0.f, 0.f};
#pragma unroll
                for (int ks = 0; ks < 4; ++ks) d = __builtin_amdgcn_mfma_f32_16x16x32_bf16(af[ks], wb[nt][ks], d, 0, 0, 0);
#pragma unroll
                for (int i = 0; i < 4; ++i) RES[(mt * 16 + 4 * g4 + i) * 64 + nt * 16 + mi] = (bf16)f2bf(d[i]);
            }
        }
        {
            const float muv = mu[1024 + tid], lg = lng[tid], lb = lnb[tid];
            float pvv = 0.f; if (t0 > 0) pvv = bf2f(Hm[(size_t)(R0 - 1) * HMW + 1024 + tid]);
#pragma unroll 1
            for (int tg = 0; tg < 4; ++tg) {
                bf16 y8[8], zv8[8]; float bn8[8];
#pragma unroll
                for (int u = 0; u < 8; ++u) { const size_t R = R0 + tg * 8 + u; y8[u] = c_Y[R * YW + tid]; zv8[u] = Hm[R * HMW + 1024 + tid]; bn8[u] = c_BON[R * 8 + h]; }
#pragma unroll
                for (int u = 0; u < 8; ++u) {
                    const int tt = tg * 8 + u;
                    const float acc = bf2f(RES[tt * 64 + lane]);
                    const size_t R = R0 + tt;
                    const float y = bf2f(y8[u]);
                    const float mean = wave_sum(y) * (1.0f / 64.0f), d = y - mean, var = wave_sum(d * d) * (1.0f / 64.0f);
                    const float yn = d * __builtin_amdgcn_rsqf(var + 64e-5f) * lg + lb;
                    const float zv = bf2f(zv8[u]); const float v = zv + muv * (pvv - zv); pvv = zv;
                    float o = (yn + bn8[u] * v) * acc;
#if SKIP_RW
                    o = 0.f;
#endif
                    c_Y[R * YW + tid] = (bf16)f2bf(o);
                }
            }
        }
        {
            unsigned yu[4][4], zz[4][4];
#pragma unroll
            for (int a = 0; a < 4; ++a)
#pragma unroll
                for (int hh = 0; hh < 4; ++hh) { const size_t R = R0 + wave + 8 * a; yu[a][hh] = *(const unsigned*)(c_Y + R * YW + 1024 + hh * 128 + 2 * lane); zz[a][hh] = *(const unsigned*)(Hm + R * HMW + C_GDZ + hh * 128 + 2 * lane); }
            const float gn0 = gng[2 * lane], gn1 = gng[2 * lane + 1];
#pragma unroll
            for (int a = 0; a < 4; ++a) {
                const size_t R = R0 + wave + 8 * a;
#pragma unroll
                for (int hh = 0; hh < 4; ++hh) {
                    const float o0 = bflo(yu[a][hh]), o1 = bfhi(yu[a][hh]);
                    const float ss = wave_sum(o0 * o0 + o1 * o1) * (1.0f / 128.0f), sc = __builtin_amdgcn_rsqf(ss + 1e-6f);
                    float r0 = o0 * sc * gn0 * siluf_(bflo(zz[a][hh])), r1 = o1 * sc * gn1 * siluf_(bfhi(zz[a][hh]));
#if SKIP_GD
                    r0 = 0.f; r1 = 0.f;
#endif
                    *(unsigned*)(c_Y + R * YW + 1024 + hh * 128 + 2 * lane) = pk2(r0, r1);
                }
#if SKIP_DA
                for (int e = lane; e < 256; e += 64) *(unsigned*)(c_Y + R * YW + 512 + 2 * e) = 0u;
#endif
            }
        }
    }
}

constexpr int PH_PER_LAYER = 20;
__global__ void __launch_bounds__(NWAVES * 64, 2) fwd_kernel(Params p) {
    extern __shared__ __attribute__((aligned(16))) unsigned char lds_raw[];
    cg::grid_group grid = cg::this_grid();
    if (p.ph_hi < 0) grid.sync();
    Ctx c;
    c.lds = (LAS unsigned char*)lds_raw; c.wv = __builtin_amdgcn_readfirstlane(threadIdx.x >> 6); c.G = gridDim.x; c.bid = blockIdx.x;
    c.X = p.out; c.ws = p.ws;
    volatile LAS unsigned* bst = (volatile LAS unsigned*)(c.lds + 131072 + 512);
    { const int t_ = threadIdx.x; if (t_ < 2) bst[t_] = 0u; }
    __syncthreads();
    const XcdBarrier bar = xcd_barrier_post((unsigned*)(p.ws + WS_BAR), bst);
    for (int ph = p.ph_lo; ph < p.ph_hi; ++ph) {
        const int l = ph / PH_PER_LAYER, k = ph % PH_PER_LAYER;
        pg8::TileOrder S;
#ifndef PHMASK
#define PHMASK 255
#endif
        if (k == 0 && l > 0) continue;
        const int wl = (l == 0 && (k == 0 || k == 19)) ? (k == 0 ? 0 : 1) : -1;
        if (k == 0) ph_x_to_bf16(c);
        else if (k == 1 || k == 17) {
            pg8::Gemm g{c_XN, c_W + (k == 1 ? W_1 : W_3), DM, DM}; S.init(MTOK, 2 * DFF, c.G, c.bid, 1);
            pg8::EpiSwiglu E{c_HB}; pg8::gemm_phase(c.lds, g, S, E, c.wv);
        } else if (k == 2 || k == 18) {
            pg8::Gemm g{c_HB, c_W + (k == 2 ? W_2 : W_4), DFF, DFF}; S.init(MTOK, DM, c.G, c.bid, 1);
            pg8::EpiResid E{(l == 0 && k == 2) ? in_ptr(0) : c.X, c.X, ALPHA, 0.5f}; pg8::gemm_phase(c.lds, g, S, E, c.wv);
        } else if (k == 3) ph_ln(c, in_ptr(3) + l * DM, in_ptr(4) + l * DM);
        else if (k == 16) ph_ln(c, in_ptr(28) + l * DM, in_ptr(29) + l * DM);
        else if (k == 19) ph_ln(c, in_ptr(32) + l * DM, in_ptr(33) + l * DM);
        else {
            const int hb = (k - 4) / 6, kk = (k - 4) % 6;
            const bf16* XNh = c_XN + (size_t)hb * MH * DM; float* Xh = c.X + (size_t)hb * MH * DM;
#if SKIP_MIX
            if (kk == 5) { pg8::Gemm g{XNh, c_W + W_O, DM, DM}; S.init(MH, DM, c.G, c.bid, 1); pg8::EpiResid E{Xh, Xh, ALPHA, 0.0f}; pg8::gemm_phase(c.lds, g, S, E, c.wv); }
#else
            if (kk == 0) { pg8::Gemm g{XNh, c_W + W_M, DM, DM}; S.init(MH, HMW, c.G, c.bid, 1); pg8::EpiHm E{c_Hm, c_Vt, HMW, 11}; pg8::gemm_phase(c.lds, g, S, E, c.wv); }
            else if (kk == 1) { if (PHMASK & 2) { ph_prep(c, l);
#ifdef REPEAT_PREP
                ph_prep(c, l);
#endif
            } }
            else if (kk == 2) { if (PHMASK & 4) { ph_mix(c, l, 7);
#ifdef REPEAT_MIX
                ph_mix(c, l, REPEAT_MIX);
#endif
            } }
            else if (kk == 3) { if (PHMASK & 8) ph_post(c, l);
                __syncthreads();
                pg8::Gemm g{XNh, c_W + W_G, DM, DM}; S.init(MH, HGW, c.G, c.bid, 1); pg8::EpiHm E{c_Hg, c_Vt, HGW, 1 << 20}; pg8::gemm_phase(c.lds, g, S, E, c.wv); }
            else if (kk == 4) { pg8::Gemm g{c_Y, c_W + W_B, YW, 512}; S.init(MH, DM, c.G, c.bid, 3); pg8::EpiMerge E{c_Hg, c_Mg}; pg8::gemm_phase(c.lds, g, S, E, c.wv); }
            else { pg8::Gemm g{c_Mg, c_W + W_O, DM, DM}; S.init(MH, DM, c.G, c.bid, 1); pg8::EpiResid E{Xh, Xh, ALPHA, 1.0f}; pg8::gemm_phase<pg8::EpiResid, 16>(c.lds, g, S, E, c.wv); }
#endif
        }
        if (wl >= 0) ph_weights(c, wl);
        if (ph + 1 < p.ph_hi || DBG_DUMP) {
#if USE_CG_SYNC
            __builtin_amdgcn_fence(__ATOMIC_RELEASE, "agent"); asm volatile("s_waitcnt vmcnt(0) lgkmcnt(0)" ::: "memory");
            grid.sync();
            __builtin_amdgcn_fence(__ATOMIC_ACQUIRE, "agent"); asm volatile("s_waitcnt vmcnt(0)" ::: "memory");
#else
            xcd_barrier(bar, c.wv);
#endif
        }
    }
#if DBG_DUMP
    {
        const bf16* src = (const bf16*)(p.ws + DBG_SRC);
        const size_t n = (size_t)DBG_N, tot = (size_t)MTOK * DM;
        for (size_t i = (size_t)blockIdx.x * 512 + threadIdx.x; i < tot; i += (size_t)gridDim.x * 512) p.out[i] = i < n ? bf2f(src[i]) : 0.f;
    }
#endif
}

extern "C" void kernel_launch(void* const* d_in, const int* in_sizes, int n_in, void* d_out, int out_size, void* d_ws, size_t ws_size, hipStream_t stream) {
    static int grid = 0;
    if (grid == 0) {
        if (n_in != 34 || out_size != MTOK * DM || ws_size < WS_END) { fprintf(stderr, "kernel_launch: unexpected problem (n_in %d out %d ws %zu)\n", n_in, out_size, ws_size); grid = -1; return; }
        int dev = 0, cus = 0, per_cu = 0;
        hipGetDevice(&dev); hipDeviceGetAttribute(&cus, hipDeviceAttributeMultiprocessorCount, dev);
        hipFuncSetAttribute((const void*)fwd_kernel, hipFuncAttributeMaxDynamicSharedMemorySize, LDS_BYTES);
        hipOccupancyMaxActiveBlocksPerMultiprocessor(&per_cu, (const void*)fwd_kernel, NWAVES * 64, LDS_BYTES);
        if (per_cu < 1) per_cu = 1;
        grid = cus * per_cu; if (grid > 256) grid = 256;
        (void)hipGetLastError();
    }
    if (grid < 0) return;
    if (hipMemsetAsync((char*)d_ws + WS_BAR, 0, XCD_BAR_WORDS * 4, stream) != hipSuccess) { fprintf(stderr, "memset failed\n"); return; }
    Params p{};
    for (int i = 0; i < 34; ++i) p.in[i] = (const float*)d_in[i];
    p.out = (float*)d_out; p.ws = (unsigned char*)d_ws; p.ph_lo = 0; p.ph_hi = DBG_HI;
    void* args[] = {&p};
    hipError_t e = hipLaunchCooperativeKernel((const void*)fwd_kernel, dim3(grid), dim3(NWAVES * 64), args, LDS_BYTES, stream);
    if (e != hipSuccess) fprintf(stderr, "cooperative launch failed: %s (grid %d)\n", hipGetErrorString(e), grid);
}
```

```cpp
#include <hip/hip_runtime.h>
#include <hip/hip_cooperative_groups.h>
#include <cstdio>
#include <cstdint>
namespace cg = cooperative_groups;

#define LAS __attribute__((address_space(3)))
typedef unsigned short bf16;
typedef short bf16x8 __attribute__((ext_vector_type(8)));
typedef float f32x4 __attribute__((ext_vector_type(4)));
typedef float f32x2 __attribute__((ext_vector_type(2)));
typedef unsigned u32x4 __attribute__((ext_vector_type(4)));
typedef unsigned u32x2 __attribute__((ext_vector_type(2)));

#ifndef USE_CG_SYNC
#define USE_CG_SYNC 0
#endif
#ifndef DBG_DUMP
#define DBG_DUMP 0
#define DBG_SRC 0
#define DBG_N 0
#define DBG_HI (2 * PH_PER_LAYER)
#endif
#ifndef SKIP_RW
#define SKIP_RW 0
#endif
#ifndef SKIP_DA
#define SKIP_DA 0
#endif
#ifndef SKIP_GD
#define SKIP_GD 0
#endif
#ifndef SKIP_MIX
#define SKIP_MIX 0
#endif

constexpr int MTOK = 32768, MH = 16384, DM = 1024, DFF = 2816, SEQ = 4096;
constexpr int HMW = 5632;
constexpr int HGW = 3072;
constexpr int YW = 1536;
constexpr int NWAVES = 8;
constexpr int LDS_BYTES = 131072 + 1024;
constexpr float ALPHA = 1.41421356237f;

constexpr int C_RW = 0, C_DA = 1792, C_DAK = 2304, C_DAV = 2816, C_GD = 3328, C_GDA = 4864, C_GDB = 4868, C_GDZ = 4872;

constexpr size_t MiB = 1u << 20;
constexpr size_t WS_BON = 0;
constexpr size_t WS_GB = 1 * MiB;
constexpr size_t WS_BAR = 2 * MiB;
constexpr size_t WS_W = 4 * MiB;
constexpr size_t WS_XN = 60 * MiB;
constexpr size_t WS_A = 124 * MiB;
constexpr size_t WS_B = 300 * MiB;
constexpr size_t WS_P6 = WS_B, WS_GQK = WS_B + 96 * MiB, WS_GV = WS_B + 128 * MiB, WS_VT = WS_B + 144 * MiB;
constexpr size_t WS_C = 460 * MiB;
constexpr size_t WS_END = 508 * MiB;
constexpr size_t W_1 = 0, W_2 = 5767168, W_M = 8650752, W_G = 14417920, W_B = 17563648, W_O = 19136512, W_3 = 20185088, W_4 = 25952256;

__device__ __forceinline__ float bf2f(bf16 b) { return __uint_as_float((unsigned)b << 16); }
__device__ __forceinline__ float bflo(unsigned u) { return __uint_as_float(u << 16); }
__device__ __forceinline__ float bfhi(unsigned u) { return __uint_as_float(u & 0xffff0000u); }
typedef __bf16 bf16x2_t __attribute__((ext_vector_type(2)));
__device__ __forceinline__ unsigned pk2(float lo, float hi) { const f32x2 v = {lo, hi}; const bf16x2_t b = __builtin_convertvector(v, bf16x2_t); return __builtin_bit_cast(unsigned, b); }
__device__ __forceinline__ unsigned f2bf(float f) { return pk2(f, f) & 0xffffu; }
__device__ __forceinline__ float sigmoidf_(float x) { return __builtin_amdgcn_rcpf(1.0f + __expf(-x)); }
__device__ __forceinline__ float siluf_(float x) { return x * sigmoidf_(x); }
__device__ __forceinline__ float tanhf_(float x) { return 1.0f - 2.0f * __builtin_amdgcn_rcpf(__expf(2.0f * x) + 1.0f); }
template <int CTRL> __device__ __forceinline__ float dppf(float x) { return __int_as_float(__builtin_amdgcn_update_dpp(0, __float_as_int(x), CTRL, 0xf, 0xf, false)); }
__device__ __forceinline__ float row_sum16(float x) {
    x += dppf<0x128>(x); x += dppf<0x124>(x); x += dppf<0x122>(x); x += dppf<0x121>(x); return x;
}


#define XB_TMO      128
#define XB_XCNT(j)  (256  + 64 * (j))
#define XB_XSUB(j)  (1280 + 64 * (j))
#define XB_XGEN(j)  (2304 + 64 * (j))
#define XB_TOP      3328
#define XB_TOPGEN   3392
#define XCD_BAR_WORDS 3456
#define XB_SPIN_CAP (1u << 22)
__device__ __forceinline__ unsigned xb_ld(unsigned* p)              { return __hip_atomic_load(p, __ATOMIC_RELAXED, __HIP_MEMORY_SCOPE_AGENT); }
__device__ __forceinline__ unsigned xb_add(unsigned* p, unsigned v) { return __hip_atomic_fetch_add(p, v, __ATOMIC_RELAXED, __HIP_MEMORY_SCOPE_AGENT); }
__device__ __forceinline__ unsigned xb_xcc_id() { return (unsigned)__builtin_amdgcn_s_getreg((3 << 11) | 20) & 0xFu; }
#define XB_SPIN(cond, bar) do { unsigned _sp = 0; while (cond) { __builtin_amdgcn_s_sleep(1); \
    if ((++_sp & 255u) == 0u) { if (xb_ld(&(bar)[XB_TMO])) break; if (_sp > XB_SPIN_CAP) { atomicAdd(&(bar)[XB_TMO], 1u); break; } } } } while (0)
struct XcdBarrier { unsigned* bar; unsigned x; volatile LAS unsigned* st; };
__device__ __forceinline__ XcdBarrier xcd_barrier_post(unsigned* bar, volatile LAS unsigned* st) {
    XcdBarrier b; b.bar = bar; b.x = xb_xcc_id(); b.st = st;
    if (threadIdx.x == 0) (void)xb_add(&bar[XB_XCNT(b.x)], 1u);
    return b;
}
__device__ __forceinline__ void xcd_barrier_complete(unsigned* bar, unsigned x, unsigned& nloc, unsigned& nx) {
    const unsigned G = gridDim.x * gridDim.y * gridDim.z;
    unsigned sum, cnt, mine, sp = 0u;
    for (;;) {
        sum = 0u; cnt = 0u; mine = 0u;
#pragma unroll
        for (unsigned j = 0; j < 16; ++j) { const unsigned c = xb_ld(&bar[XB_XCNT(j)]); sum += c; cnt += (c > 0u) ? 1u : 0u; mine = (j == x) ? c : mine; }
        if (sum == G) break;
        __builtin_amdgcn_s_sleep(1);
        if ((++sp & 255u) == 0u) { if (xb_ld(&bar[XB_TMO])) break; if (sp > XB_SPIN_CAP) { atomicAdd(&bar[XB_TMO], 1u); break; } }
    }
    nloc = mine > 0u ? mine : 1u; nx = cnt > 0u ? cnt : 1u;
}
__device__ __forceinline__ void xcd_barrier(const XcdBarrier& b, const int wv) {
    asm volatile("s_waitcnt vmcnt(0)" ::: "memory");
    __syncthreads();
    if (wv == 0 && __builtin_amdgcn_mbcnt_hi(~0u, __builtin_amdgcn_mbcnt_lo(~0u, 0u)) == 0u) {
        unsigned* bar = b.bar;
        __builtin_amdgcn_s_waitcnt(0);
        unsigned nloc = b.st[0], nx = b.st[1];
        if (nloc == 0u) { xcd_barrier_complete(bar, b.x, nloc, nx); b.st[0] = nloc; b.st[1] = nx; }
        const unsigned old = xb_add(&bar[XB_XSUB(b.x)], 1u);
        const unsigned gen = old / nloc;
        if (old + 1u == (gen + 1u) * nloc) {
            __builtin_amdgcn_fence(__ATOMIC_RELEASE, "agent");
            asm volatile("s_waitcnt vmcnt(0)" ::: "memory");
            const unsigned og = xb_add(&bar[XB_TOP], 1u);
            const unsigned tg = og / nx;
            if (og + 1u == (tg + 1u) * nx) xb_add(&bar[XB_TOPGEN], 1u);
            else XB_SPIN(xb_ld(&bar[XB_TOPGEN]) == tg, bar);
            __builtin_amdgcn_fence(__ATOMIC_ACQUIRE, "agent");
            xb_add(&bar[XB_XGEN(b.x)], 1u);
            asm volatile("s_waitcnt vmcnt(0)" ::: "memory");
        } else {
            XB_SPIN(xb_ld(&bar[XB_XGEN(b.x)]) == gen, bar);
            __builtin_amdgcn_fence(__ATOMIC_ACQUIRE, "agent");
            asm volatile("s_waitcnt vmcnt(0)" ::: "memory");
        }
    }
    __syncthreads();
}

__device__ __forceinline__ void row_sum16x2(float& a, float& b) {
    a += dppf<0x128>(a); b += dppf<0x128>(b); a += dppf<0x124>(a); b += dppf<0x124>(b); a += dppf<0x122>(a); b += dppf<0x122>(b); a += dppf<0x121>(a); b += dppf<0x121>(b);
}
__device__ __forceinline__ float wave_sum(float v) {
    v = row_sum16(v);
    const int iv = __float_as_int(v);
    return (__int_as_float(__builtin_amdgcn_readlane(iv, 0)) + __int_as_float(__builtin_amdgcn_readlane(iv, 16))) + (__int_as_float(__builtin_amdgcn_readlane(iv, 32)) + __int_as_float(__builtin_amdgcn_readlane(iv, 48)));
}
namespace pg8 {
constexpr int BM = 256, BK = 64, HALF = 128, HTB = HALF * BK * 2, STAGE_BYTES = 8 * HTB, NXCD = 8, WGM = 8;
__host__ __device__ __forceinline__ int lds_byte(int r, int c) { const int st = (r >> 4) * 2 + (c >> 5), rr = r & 15, cc = c & 31, ob = rr * 64 + cc * 2; return st * 1024 + (ob ^ (((ob >> 9) & 1) << 5)); }
__host__ __device__ __forceinline__ void stage_rc(int b, int& R, int& C) { const int st = b / 1024, sb = b % 1024, swz = sb ^ (((sb >> 9) & 1) << 5); R = (st >> 1) * 16 + swz / 64; C = (st & 1) * 32 + (swz % 64) / 2; }
__host__ __device__ __forceinline__ int perm32(int rho) { const int n = rho >> 4, i = rho & 15; return 8 * (i >> 2) + 4 * n + (i & 3); }

struct Unit { int pm, pn, aofs, tag; };
struct Gemm { const bf16* A; const bf16* Bt; int lda, K; };

struct TileOrder {
    int nM, nN, nwg, G, c, nbr;
    __device__ void init(int M, int N, int G_, int c_, int nbr_) { nM = M / BM; nN = N / BM; nwg = nM * nN; G = G_; c = c_; nbr = nbr_; }
    __device__ bool next(int i, Unit& u) const {
        const int it = i / nbr, br = i - it * nbr;
        const long L = (long)it * G + c; if (L >= nwg) return false;
        int wgid = (int)L; { const int q = nwg / NXCD, r = nwg % NXCD, xcd = wgid % NXCD, off = wgid / NXCD; wgid = (xcd < r ? xcd * (q + 1) : r * (q + 1) + (xcd - r) * q) + off; }
        const int nig = WGM * nN, gid = wgid / nig, fm = gid * WGM, gsz = (nM - fm) < WGM ? (nM - fm) : WGM;
        u.pm = fm + ((wgid % nig) % gsz); u.pn = (wgid % nig) / gsz + br * nN; u.aofs = br * 1024; u.tag = br; return true;
    }
};

template <class Epi, int A_AUX = 0>
__device__ __forceinline__ void gemm_phase(LAS unsigned char* lds, const Gemm g, const TileOrder& S, const Epi& E, const int wid) {
    int lane = (int)__builtin_amdgcn_mbcnt_hi(~0u, __builtin_amdgcn_mbcnt_lo(~0u, 0u)); asm volatile("" : "+v"(lane));
    const int tid = wid * 64 + lane, wr = wid >> 2, wc = wid & 3, fr = lane & 15, fq = lane >> 4;
    const int K = g.K, nt = K / BK, lda = g.lda;
    unsigned voffA[2], voffB[2];
#pragma unroll
    for (int i = 0; i < 2; ++i) { int R, C; stage_rc(tid * 16 + i * 8192, R, C); const int Rb = Epi::PERM ? ((R & ~31) + perm32(R & 31)) : R;
        voffA[i] = (unsigned)(R * lda + C) * 2u; voffB[i] = (unsigned)(Rb * K + C) * 2u; }
    const size_t kstep = (size_t)(BK * 2);
    const size_t hstepA = (size_t)HALF * lda * 2, hstepB = (size_t)HALF * K * 2;
    const size_t tstepA = 2 * hstepA, tstepB = 2 * hstepB;
    const unsigned ldsw = (unsigned)wid * 1024u;
    const int aoff = lds_byte(wr * 64 + fr, fq * 8), boff = lds_byte(wc * 32 + fr, fq * 8);
#define PG8_SA(b, h) (((b) * 2 + (h)) * HTB)
#define PG8_SB(b, h) ((4 + (b) * 2 + (h)) * HTB)
#define PG8_STAGE_X(bufoff, gbase, voff, AUX) do { _Pragma("unroll") for (int _i = 0; _i < 2; ++_i) \
        __builtin_amdgcn_global_load_lds((const unsigned*)((const char*)(gbase) + (voff)[_i]), (LAS unsigned*)(lds + (bufoff) + ldsw + _i * 8192), 16, 0, AUX); } while (0)
#define PG8_STAGE(bufoff, gbase, voff) PG8_STAGE_X(bufoff, gbase, voff, 0)
#define PG8_STAGEA(bufoff, gbase, voff) PG8_STAGE_X(bufoff, gbase, voff, A_AUX)
#define PG8_LDA(dst, b, h) do { _Pragma("unroll") for (int m = 0; m < 4; ++m) _Pragma("unroll") for (int k = 0; k < 2; ++k) dst[m][k] = *(const LAS bf16x8*)(lds + PG8_SA(b, h) + aoff + m * 2048 + k * 1024); } while (0)
#define PG8_LDB(dst, b, h) do { _Pragma("unroll") for (int n = 0; n < 2; ++n) _Pragma("unroll") for (int k = 0; k < 2; ++k) dst[n][k] = *(const LAS bf16x8*)(lds + PG8_SB(b, h) + boff + n * 2048 + k * 1024); } while (0)
#define PG8_MMA(ai, bj, At, Bt) do { __builtin_amdgcn_s_setprio(1); _Pragma("unroll") for (int m = 0; m < 4; ++m) _Pragma("unroll") for (int n = 0; n < 2; ++n) _Pragma("unroll") for (int k = 0; k < 2; ++k) \
        acc[ai][bj][m][n] = __builtin_amdgcn_mfma_f32_16x16x32_bf16(Bt[n][k], At[m][k], acc[ai][bj][m][n], 0, 0, 0); __builtin_amdgcn_s_setprio(0); } while (0)
#define PG8_WAIT_V(n) asm volatile("s_waitcnt vmcnt(" #n ")" ::: "memory")
#define PG8_WAIT_L(n) asm volatile("s_waitcnt lgkmcnt(" #n ")" ::: "memory")
#define PG8_BAR __builtin_amdgcn_s_barrier()
#define PG8_SCHED __builtin_amdgcn_sched_barrier(0)
    Unit cur, nxt; int ui = 0;
    if (!S.next(0, cur)) return;
    f32x4 acc[2][2][4][2];
#pragma unroll
    for (int a = 0; a < 2; ++a)
#pragma unroll
        for (int b = 0; b < 2; ++b)
#pragma unroll
            for (int m = 0; m < 4; ++m)
#pragma unroll
                for (int n = 0; n < 2; ++n) acc[a][b][m][n] = (f32x4){0.f, 0.f, 0.f, 0.f};
    bf16x8 At[4][2], B0[2][2], B1[2][2];
    const char* cA = (const char*)g.A + (size_t)cur.pm * tstepA + cur.aofs; const char* cB = (const char*)g.Bt + (size_t)cur.pn * tstepB;
    {
        PG8_STAGE(PG8_SB(0, 0), cB, voffB); PG8_STAGE(PG8_SB(0, 1), cB + hstepB, voffB); PG8_STAGEA(PG8_SA(0, 0), cA, voffA); PG8_STAGEA(PG8_SA(0, 1), cA + hstepA, voffA);
        if (wr == 1) PG8_BAR;
        PG8_WAIT_V(2); PG8_BAR;
        PG8_STAGE(PG8_SB(1, 0), cB + kstep, voffB); PG8_STAGEA(PG8_SA(1, 0), cA + kstep, voffA); PG8_STAGE(PG8_SB(1, 1), cB + hstepB + kstep, voffB);
        PG8_WAIT_V(6); PG8_BAR;
    }
    for (;;) {
        const bool has_next = S.next(ui + 1, nxt);
        const char* nA = has_next ? (const char*)g.A + (size_t)nxt.pm * tstepA + nxt.aofs : cA; const char* nB = has_next ? (const char*)g.Bt + (size_t)nxt.pn * tstepB : cB;
        for (int t = 0; t < nt; t += 2) {
            const bool last = (t == nt - 2);
            const char* a1 = cA + (size_t)(t + 1) * kstep;
            const char* a2 = last ? nA : cA + (size_t)(t + 2) * kstep; const char* b2 = last ? nB : cB + (size_t)(t + 2) * kstep;
            const char* a3 = a2 + kstep; const char* b3 = b2 + kstep;
            PG8_LDB(B0, 0, 0); PG8_LDB(B1, 0, 1); PG8_SCHED; PG8_LDA(At, 0, 0); PG8_STAGEA(PG8_SA(1, 1), a1 + hstepA, voffA);
            PG8_WAIT_V(8); PG8_WAIT_L(0); PG8_BAR; PG8_MMA(0, 0, At, B0); PG8_MMA(0, 1, At, B1); PG8_BAR; PG8_SCHED;
            PG8_LDA(At, 0, 1); PG8_STAGE(PG8_SB(0, 0), b2, voffB); PG8_STAGE(PG8_SB(0, 1), b2 + hstepB, voffB); PG8_STAGEA(PG8_SA(0, 0), a2, voffA);
            PG8_WAIT_V(8); PG8_WAIT_L(0); PG8_BAR; PG8_MMA(1, 0, At, B0); PG8_MMA(1, 1, At, B1); PG8_BAR; PG8_SCHED;
            PG8_LDB(B0, 1, 0); PG8_LDB(B1, 1, 1); PG8_SCHED; PG8_LDA(At, 1, 0); PG8_STAGEA(PG8_SA(0, 1), a2 + hstepA, voffA);
            PG8_WAIT_V(8); PG8_WAIT_L(0); PG8_BAR; PG8_MMA(0, 0, At, B0); PG8_MMA(0, 1, At, B1); PG8_BAR; PG8_SCHED;
            PG8_LDA(At, 1, 1); PG8_STAGE(PG8_SB(1, 0), b3, voffB); PG8_STAGE(PG8_SB(1, 1), b3 + hstepB, voffB); PG8_STAGEA(PG8_SA(1, 0), a3, voffA);
            PG8_WAIT_V(8); PG8_WAIT_L(0); PG8_BAR; PG8_MMA(1, 0, At, B0); PG8_MMA(1, 1, At, B1); PG8_BAR; PG8_SCHED;
        }
        if (wr == 0) PG8_BAR;
        E(acc, cur, wr, wc, fr, fq);
        if (!has_next) break;
#pragma unroll
        for (int a = 0; a < 2; ++a)
#pragma unroll
            for (int b = 0; b < 2; ++b)
#pragma unroll
                for (int m = 0; m < 4; ++m)
#pragma unroll
                    for (int n = 0; n < 2; ++n) acc[a][b][m][n] = (f32x4){0.f, 0.f, 0.f, 0.f};
        cur = nxt; cA = nA; cB = nB; ++ui;
        if (wr == 1) PG8_BAR;
    }
    PG8_WAIT_V(0);
    PG8_BAR;
#undef PG8_SA
#undef PG8_SB
#undef PG8_STAGE
#undef PG8_STAGEA
#undef PG8_STAGE_X
#undef PG8_LDA
#undef PG8_LDB
#undef PG8_MMA
#undef PG8_WAIT_V
#undef PG8_WAIT_L
#undef PG8_BAR
#undef PG8_SCHED
}

typedef f32x4 Acc[2][2][4][2];

struct EpiSwiglu {
    static constexpr bool PERM = true; bf16* O;
    __device__ __forceinline__ void operator()(const Acc& acc, const Unit& u, int wr, int wc, int fr, int fq) const {
        const int row0 = u.pm * BM + wr * 64 + fr, col0 = u.pn * 128 + wc * 32 + 8 * fq;
#pragma unroll
        for (int ai = 0; ai < 2; ++ai)
#pragma unroll
            for (int m = 0; m < 4; ++m) {
                bf16* rowp = O + (size_t)(row0 + ai * HALF + m * 16) * DFF + col0;
                const f32x4 g0 = acc[ai][0][m][0], g1 = acc[ai][0][m][1], u0 = acc[ai][1][m][0], u1 = acc[ai][1][m][1];
                u32x4 w;
                w.x = pk2(siluf_(g0[0]) * u0[0], siluf_(g0[1]) * u0[1]); w.y = pk2(siluf_(g0[2]) * u0[2], siluf_(g0[3]) * u0[3]);
                w.z = pk2(siluf_(g1[0]) * u1[0], siluf_(g1[1]) * u1[1]); w.w = pk2(siluf_(g1[2]) * u1[2], siluf_(g1[3]) * u1[3]);
                *(u32x4*)rowp = w;
            }
    }
};
struct EpiResid {
    static constexpr bool PERM = false; const float* base; float* out; float alpha, s;
    __device__ __forceinline__ void operator()(const Acc& acc, const Unit& u, int wr, int wc, int fr, int fq) const {
        const int col0 = u.pn * BM + wc * 32 + 4 * fq;
#pragma unroll
        for (int ai = 0; ai < 2; ++ai)
#pragma unroll
            for (int m = 0; m < 4; ++m) {
                const size_t off = (size_t)(u.pm * BM + ai * HALF + wr * 64 + m * 16 + fr) * DM + col0;
#pragma unroll
                for (int bj = 0; bj < 2; ++bj)
#pragma unroll
                    for (int n = 0; n < 2; ++n) { const f32x4 b = *(const f32x4*)(base + off + bj * HALF + n * 16); *(f32x4*)(out + off + bj * HALF + n * 16) = b * alpha + acc[ai][bj][m][n] * s; }
            }
    }
};
struct EpiHm {
    static constexpr bool PERM = true; bf16* O; bf16* Vt; int ldc, vlo;
    __device__ __forceinline__ void operator()(const Acc& acc, const Unit& u, int wr, int wc, int fr, int fq) const {
        const int row0 = u.pm * BM + wr * 64 + fr;
        if (u.pn == vlo || u.pn == vlo + 1) {
#pragma unroll
            for (int ai = 0; ai < 2; ++ai)
#pragma unroll
                for (int m = 0; m < 4; ++m) {
                    const int r = row0 + ai * HALF + m * 16, bl = r >> 12, t = r & 4095;
#pragma unroll
                    for (int bj = 0; bj < 2; ++bj)
#pragma unroll
                        for (int n = 0; n < 2; ++n)
#pragma unroll
                            for (int e = 0; e < 4; ++e) {
                                const int cv = (u.pn - vlo) * 256 + bj * HALF + wc * 32 + 8 * fq + 4 * n + e;
                                Vt[((size_t)(bl * 4 + (cv >> 7)) * 128 + (cv & 127)) * SEQ + t] = (bf16)f2bf(acc[ai][bj][m][n][e]);
                            }
                }
            return;
        }
        const int col0 = u.pn * BM + wc * 32 + 8 * fq;
#pragma unroll
        for (int ai = 0; ai < 2; ++ai)
#pragma unroll
            for (int m = 0; m < 4; ++m) {
                bf16* rowp = O + (size_t)(row0 + ai * HALF + m * 16) * ldc + col0;
#pragma unroll
                for (int bj = 0; bj < 2; ++bj) { const f32x4 v0 = acc[ai][bj][m][0], v1 = acc[ai][bj][m][1]; u32x4 w; w.x = pk2(v0[0], v0[1]); w.y = pk2(v0[2], v0[3]); w.z = pk2(v1[0], v1[1]); w.w = pk2(v1[2], v1[3]); *(u32x4*)(rowp + bj * HALF) = w; }
            }
    }
};
struct EpiMerge {
    static constexpr bool PERM = true; const bf16* Hg; bf16* Mg;
    __device__ __forceinline__ void operator()(const Acc& acc, const Unit& u, int wr, int wc, int fr, int fq) const {
        const int br = u.tag, pn4 = u.pn - 4 * br;
        const int row0 = u.pm * BM + wr * 64 + fr, col0 = pn4 * BM + wc * 32 + 8 * fq;
#pragma unroll
        for (int ai = 0; ai < 2; ++ai)
#pragma unroll
            for (int m = 0; m < 4; ++m) {
                const int r = row0 + ai * HALF + m * 16;
#pragma unroll
                for (int bj = 0; bj < 2; ++bj) {
                    const unsigned long long* gq = (const unsigned long long*)(Hg + (size_t)r * HGW + br * 1024 + col0 + bj * HALF);
                    const unsigned long long g0 = __hip_atomic_load(gq, __ATOMIC_RELAXED, __HIP_MEMORY_SCOPE_AGENT), g1 = __hip_atomic_load(gq + 1, __ATOMIC_RELAXED, __HIP_MEMORY_SCOPE_AGENT);
                    u32x4 gt; gt.x = (unsigned)g0; gt.y = (unsigned)(g0 >> 32); gt.z = (unsigned)g1; gt.w = (unsigned)(g1 >> 32);
                    bf16* mp = Mg + (size_t)r * DM + col0 + bj * HALF;
                    const f32x4 v0 = acc[ai][bj][m][0], v1 = acc[ai][bj][m][1];
                    float o[8] = {sigmoidf_(bflo(gt.x)) * v0[0], sigmoidf_(bfhi(gt.x)) * v0[1], sigmoidf_(bflo(gt.y)) * v0[2], sigmoidf_(bfhi(gt.y)) * v0[3], sigmoidf_(bflo(gt.z)) * v1[0], sigmoidf_(bfhi(gt.z)) * v1[1], sigmoidf_(bflo(gt.w)) * v1[2], sigmoidf_(bfhi(gt.w)) * v1[3]};
                    if (br > 0) {
                        const unsigned long long q0 = __hip_atomic_load((const unsigned long long*)mp, __ATOMIC_RELAXED, __HIP_MEMORY_SCOPE_AGENT), q1 = __hip_atomic_load((const unsigned long long*)mp + 1, __ATOMIC_RELAXED, __HIP_MEMORY_SCOPE_AGENT);
                        u32x4 od; od.x = (unsigned)q0; od.y = (unsigned)(q0 >> 32); od.z = (unsigned)q1; od.w = (unsigned)(q1 >> 32); o[0] += bflo(od.x); o[1] += bfhi(od.x); o[2] += bflo(od.y); o[3] += bfhi(od.y); o[4] += bflo(od.z); o[5] += bfhi(od.z); o[6] += bflo(od.w); o[7] += bfhi(od.w); }
                    u32x4 w; w.x = pk2(o[0], o[1]); w.y = pk2(o[2], o[3]); w.z = pk2(o[4], o[5]); w.w = pk2(o[6], o[7]); *(u32x4*)mp = w;
                }
            }
    }
};
}

struct Params { const float* in[34]; float* out; unsigned char* ws; int ph_lo, ph_hi; };

struct Ctx {
    LAS unsigned char* lds; int G, bid, wv;
    float* X; unsigned char* ws;
};
#define c_W   ((bf16*)(c.ws + WS_W))
#define c_XN  ((bf16*)(c.ws + WS_XN))
#define c_HB  ((bf16*)(c.ws + WS_A))
#define c_Hm  ((bf16*)(c.ws + WS_A))
#define c_Mg  ((bf16*)(c.ws + WS_A))
#define c_P6  ((bf16*)(c.ws + WS_P6))
#define c_GQK ((bf16*)(c.ws + WS_GQK))
#define c_GV  ((bf16*)(c.ws + WS_GV))
#define c_Vt  ((bf16*)(c.ws + WS_VT))
#define c_Hg  ((bf16*)(c.ws + WS_P6))
#define c_Y   ((bf16*)(c.ws + WS_C))
#define c_BON ((float*)(c.ws + WS_BON))
#define c_GB  ((float*)(c.ws + WS_GB))
__device__ __forceinline__ const float* in_ptr(int i) {
    const char __attribute__((address_space(4)))* ka = (const char __attribute__((address_space(4)))*)__builtin_amdgcn_kernarg_segment_ptr();
    asm volatile("" : "+s"(ka));
    return *(const float* const __attribute__((address_space(4)))*)(ka + 8 * i);
}
#define PHASE_IDS() const int wave = c.wv; int lane = (int)__builtin_amdgcn_mbcnt_hi(~0u, __builtin_amdgcn_mbcnt_lo(~0u, 0u)); asm volatile("" : "+v"(lane)); const int tid = wave * 64 + lane; (void)tid

template <int MODE> __device__ __forceinline__ int wrow_map(int j) {
    if (MODE == 1) { const int up = j >= DFF, i = up ? j - DFF : j; return (i >> 7) * 256 + up * 128 + (i & 127); }
    if (MODE == 2) return j < 5384 ? j : 5632 + (j - 5384);
    return j;
}
template <int MODE> __device__ __forceinline__ void transpose_item(const float* W, int K, int N, bf16* WT, int row_off, LAS float* scr, int item, int lane) {
    const int nblk = (N + 31) / 32, kb = item / nblk, nb = item % nblk, k0 = 64 * kb, n0 = 32 * nb;
    const int colr = n0 + (lane & 31);
    float tv[32];
#pragma unroll
    for (int i = 0; i < 32; ++i) { const int kk = 2 * i + (lane >> 5); tv[i] = colr < N ? W[(size_t)(k0 + kk) * N + colr] : 0.f; }
#pragma unroll
    for (int i = 0; i < 32; ++i) { const int kk = 2 * i + (lane >> 5); scr[kk * 33 + (lane & 31)] = tv[i]; }
    asm volatile("s_waitcnt lgkmcnt(0)" ::: "memory");
    const int c = lane & 7;
#pragma unroll
    for (int j = 0; j < 4; ++j) { const int n = (lane >> 3) + 8 * j; const LAS float* s = scr + (8 * c) * 33 + n;
        u32x4 o; o.x = pk2(s[0 * 33], s[1 * 33]); o.y = pk2(s[2 * 33], s[3 * 33]); o.z = pk2(s[4 * 33], s[5 * 33]); o.w = pk2(s[6 * 33], s[7 * 33]);
        if (n0 + n < N) *(u32x4*)(WT + (size_t)(row_off + wrow_map<MODE>(n0 + n)) * K + k0 + 8 * c) = o; }
    asm volatile("s_waitcnt lgkmcnt(0)" ::: "memory");
}
__device__ __forceinline__ void ph_weights(const Ctx& c, int l) {
    PHASE_IDS();
    LAS float* scr = (LAS float*)(c.lds + wave * 16384);
    const int gw = c.bid * NWAVES + wave, NGW = c.G * NWAVES;
    constexpr int I1 = 16 * 176, I2 = 44 * 32, I3 = 16 * 265, I4 = 8 * 32, I5 = 16 * 32;
    constexpr int NIT = I1 + I2 + I3 + 3 * I4 + I5 + I1 + I2;
    const float* w1 = in_ptr(1) + (size_t)l * DM * 2 * DFF; const float* w2 = in_ptr(2) + (size_t)l * DFF * DM;
    const float* wm = in_ptr(5) + (size_t)l * DM * 8456; const float* wb = in_ptr(26) + (size_t)l * 3 * 512 * DM; const float* wo = in_ptr(27) + (size_t)l * DM * DM;
    const float* w3 = in_ptr(30) + (size_t)l * DM * 2 * DFF; const float* w4 = in_ptr(31) + (size_t)l * DFF * DM;
    for (int it = gw; it < NIT; it += NGW) {
        int r = it;
        if (r < I1) { transpose_item<1>(w1, DM, 2 * DFF, c_W + W_1, 0, scr, r, lane); continue; } r -= I1;
        if (r < I2) { transpose_item<0>(w2, DFF, DM, c_W + W_2, 0, scr, r, lane); continue; } r -= I2;
        if (r < I3) { transpose_item<2>(wm, DM, 8456, c_W + W_M, 0, scr, r, lane); continue; } r -= I3;
        if (r < 3 * I4) { const int br = r / I4; transpose_item<0>(wb + (size_t)br * 512 * DM, 512, DM, c_W + W_B, br * 1024, scr, r - br * I4, lane); continue; } r -= 3 * I4;
        if (r < I5) { transpose_item<0>(wo, DM, DM, c_W + W_O, 0, scr, r, lane); continue; } r -= I5;
        if (r < I1) { transpose_item<1>(w3, DM, 2 * DFF, c_W + W_3, 0, scr, r, lane); continue; } r -= I1;
        transpose_item<0>(w4, DFF, DM, c_W + W_4, 0, scr, r, lane);
    }
}

__device__ __forceinline__ void ph_ln(const Ctx& c, const float* g, const float* b) {
    PHASE_IDS();
    const int gw = c.bid * NWAVES + wave, NGW = c.G * NWAVES;
    f32x4 gv[4], bv[4];
#pragma unroll
    for (int j = 0; j < 4; ++j) { gv[j] = *((const f32x4*)g + lane + 64 * j); bv[j] = *((const f32x4*)b + lane + 64 * j); }
    for (int m0 = gw; m0 < MTOK; m0 += 8 * NGW) {
        f32x4 v[8][4];
#pragma unroll
        for (int r = 0; r < 8; ++r) { const int mr = (m0 + r * NGW) < MTOK ? (m0 + r * NGW) : m0; const f32x4* xr = (const f32x4*)(c.X + (size_t)mr * DM) + lane;
#pragma unroll
            for (int j = 0; j < 4; ++j) v[r][j] = xr[64 * j]; }
#pragma unroll
        for (int r = 0; r < 8; ++r) {
            const int m = m0 + r * NGW; if (m >= MTOK) break;
            f32x4* xr = (f32x4*)(c.X + (size_t)m * DM) + lane;
            float s = 0.f;
#pragma unroll
            for (int j = 0; j < 4; ++j) s += (v[r][j].x + v[r][j].y) + (v[r][j].z + v[r][j].w);
            const float mean = wave_sum(s) * (1.f / DM); float s2 = 0.f;
#pragma unroll
            for (int j = 0; j < 4; ++j) { v[r][j] = v[r][j] - mean; s2 += (v[r][j].x * v[r][j].x + v[r][j].y * v[r][j].y) + (v[r][j].z * v[r][j].z + v[r][j].w * v[r][j].w); }
            const float rstd = __builtin_amdgcn_rsqf(wave_sum(s2) * (1.f / DM) + 1e-5f);
            u32x2* o8 = (u32x2*)(c_XN + (size_t)m * DM) + lane;
#pragma unroll
            for (int j = 0; j < 4; ++j) { const f32x4 y = v[r][j] * rstd * gv[j] + bv[j]; xr[64 * j] = y; u32x2 w; w.x = pk2(y.x, y.y); w.y = pk2(y.z, y.w); o8[64 * j] = w; }
        }
    }
}
__device__ __forceinline__ void ph_x_to_bf16(const Ctx& c) {
    PHASE_IDS();
    const int gw = c.bid * NWAVES + wave, NGW = c.G * NWAVES;
    const float* xin = in_ptr(0);
    for (int m0 = gw; m0 < MTOK; m0 += 8 * NGW) {
        f32x4 y[8][4];
#pragma unroll
        for (int r = 0; r < 8; ++r) { const int mr = (m0 + r * NGW) < MTOK ? (m0 + r * NGW) : m0; const f32x4* xr = (const f32x4*)(xin + (size_t)mr * DM) + lane;
#pragma unroll
            for (int j = 0; j < 4; ++j) y[r][j] = xr[64 * j]; }
#pragma unroll
        for (int r = 0; r < 8; ++r) { const int m = m0 + r * NGW; if (m >= MTOK) break; u32x2* o8 = (u32x2*)(c_XN + (size_t)m * DM) + lane;
#pragma unroll
            for (int j = 0; j < 4; ++j) { u32x2 w; w.x = pk2(y[r][j].x, y[r][j].y); w.y = pk2(y[r][j].z, y[r][j].w); o8[64 * j] = w; } }
    }
}

__device__ __forceinline__ void ph_prep(const Ctx& c, int l) {
    LAS bf16* ACT = (LAS bf16*)c.lds;
    const float* mu = in_ptr(6) + l * 1792; const float* w0 = in_ptr(7) + l * 512; const float* wup = in_ptr(8) + l * 64 * 512;
    const float* a0 = in_ptr(9) + l * 512; const float* aup = in_ptr(10) + l * 64 * 512;
    const float* kkw = in_ptr(12) + l * 512; const float* kaw = in_ptr(13) + l * 512; const float* rkw = in_ptr(14) + l * 512;
    const float* convw = in_ptr(22) + l * 4 * 1536; const float* alog = in_ptr(23) + l * 4; const float* dtb = in_ptr(24) + l * 4;
    PHASE_IDS(); const bf16* Hm = c_Hm; const int h = wave;
    LAS bf16* RES = (LAS bf16*)(c.lds + 16384) + wave * 4096;
    const int mi = lane & 15, g4 = lane >> 4;
    bf16x8 wb[2][4][2];
#pragma unroll
    for (int mv = 0; mv < 2; ++mv)
#pragma unroll
        for (int nt = 0; nt < 4; ++nt)
#pragma unroll
            for (int ks = 0; ks < 2; ++ks) { const float* W = (mv ? aup : wup) + (size_t)(32 * ks + 8 * g4) * 512 + h * 64 + nt * 16 + mi;
                u32x4 pw; pw.x = pk2(W[0], W[512]); pw.y = pk2(W[1024], W[1536]); pw.z = pk2(W[2048], W[2560]); pw.w = pk2(W[3072], W[3584]); wb[mv][nt][ks] = __builtin_bit_cast(bf16x8, pw); }
    for (int tile = c.bid; tile < MH / 32; tile += c.G) {
        const int R0 = tile * 32, t0 = R0 & (SEQ - 1);
        __syncthreads();
#pragma unroll
        for (int e = tid; e < 32 * 128; e += 512) { const int tt = e >> 7, j = e & 127, col = 1536 + j, R = R0 + tt; const float z = bf2f(Hm[(size_t)R * HMW + col]);
            const float pv = (t0 + tt) > 0 ? bf2f(Hm[(size_t)(R - 1) * HMW + col]) : 0.f; const float s = z + mu[col] * (pv - z);
            ACT[((j < 64 ? 0 : 32) + tt) * 72 + (j & 63)] = (bf16)f2bf(j < 64 ? tanhf_(s) : s); }
        __syncthreads();
#pragma unroll
        for (int mv = 0; mv < 2; ++mv)
#pragma unroll
            for (int mt = 0; mt < 2; ++mt) {
                const bf16x8 af0 = *(const LAS bf16x8*)(ACT + (mv * 32 + mt * 16 + mi) * 72 + 8 * g4), af1 = *(const LAS bf16x8*)(ACT + (mv * 32 + mt * 16 + mi) * 72 + 32 + 8 * g4);
#pragma unroll
                for (int nt = 0; nt < 4; ++nt) {
                    f32x4 d = __builtin_amdgcn_mfma_f32_16x16x32_bf16(af0, wb[mv][nt][0], (f32x4){0.f, 0.f, 0.f, 0.f}, 0, 0, 0);
                    d = __builtin_amdgcn_mfma_f32_16x16x32_bf16(af1, wb[mv][nt][1], d, 0, 0, 0);
#pragma unroll
                    for (int i = 0; i < 4; ++i) RES[(mv * 32 + mt * 16 + 4 * g4 + i) * 64 + nt * 16 + mi] = (bf16)f2bf(d[i]);
                }
            }
        {
            const float bias = w0[tid];
#pragma unroll 8
            for (int tt = 0; tt < 32; ++tt) {
                const float acc = bias + bf2f(RES[tt * 64 + lane]);
                const float w = __expf(-0.6065306597126334f * sigmoidf_(acc));
                c_P6[((size_t)(R0 + tt) * 8 + h) * 384 + 64 + lane] = (bf16)f2bf(w);
            }
        }
        {
            const float bias = a0[tid], mur = mu[tid], muk = mu[512 + tid], muv = mu[1024 + tid], kk_ = kkw[tid], ka_ = kaw[tid], rk_ = rkw[tid];
            float pr = 0.f, pk = 0.f, pvv = 0.f;
            if (t0 > 0) { const bf16* hp = Hm + (size_t)(R0 - 1) * HMW; pr = bf2f(hp[tid]); pk = bf2f(hp[512 + tid]); pvv = bf2f(hp[1024 + tid]); }
#pragma unroll 1
            for (int tg = 0; tg < 4; ++tg) {
                bf16 zr8[8], zk8[8], zv8[8];
#pragma unroll
                for (int u = 0; u < 8; ++u) { const bf16* hp = Hm + (size_t)(R0 + tg * 8 + u) * HMW; zr8[u] = hp[tid]; zk8[u] = hp[512 + tid]; zv8[u] = hp[1024 + tid]; }
#pragma unroll
                for (int u = 0; u < 8; ++u) {
                    const int tt = tg * 8 + u;
                    const float a = sigmoidf_(bias + bf2f(RES[(32 + tt) * 64 + lane]));
                    const float zr = bf2f(zr8[u]), zk = bf2f(zk8[u]), zv = bf2f(zv8[u]);
                    const float r = zr + mur * (pr - zr), k = zk + muk * (pk - zk), v = zv + muv * (pvv - zv);
                    pr = zr; pk = zk; pvv = zv;
                    const float kx = k * kk_; const float ss = wave_sum(kx * kx); const float kk = kx * __builtin_amdgcn_rsqf(ss + 1e-6f);
                    const float kt = k * (1.0f + (a - 1.0f) * ka_);
                    const float bn = wave_sum(r * kt * rk_);
                    bf16* q = c_P6 + ((size_t)(R0 + tt) * 8 + h) * 384 + lane;
                    q[0] = (bf16)f2bf(r); q[128] = (bf16)f2bf(kt); q[192] = (bf16)f2bf(v); q[256] = (bf16)f2bf(kk); q[320] = (bf16)f2bf(kk * a);
                    if (lane == 0) c_BON[(size_t)(R0 + tt) * 8 + h] = bn;
                }
            }
        }
        for (int tk = wave; tk < 24; tk += 8) {
            const int kh = tk % 12, th = tk / 12, kind = kh >> 2, head = kh & 3, ch = kind * 512 + head * 128 + 2 * lane;
            float cw[4][2];
#pragma unroll
            for (int j = 0; j < 4; ++j) { cw[j][0] = convw[j * 1536 + ch]; cw[j][1] = convw[j * 1536 + ch + 1]; }
            const int Rs = R0 + 16 * th, ts = t0 + 16 * th;
            float x[3][2];
#pragma unroll
            for (int k = 0; k < 3; ++k) { x[k][0] = 0.f; x[k][1] = 0.f; if (ts - 3 + k >= 0) { const unsigned u = *(const unsigned*)(Hm + (size_t)(Rs - 3 + k) * HMW + C_GD + ch); x[k][0] = bflo(u); x[k][1] = bfhi(u); } }
            unsigned uu[16];
#pragma unroll
            for (int i = 0; i < 16; ++i) uu[i] = *(const unsigned*)(Hm + (size_t)(Rs + i) * HMW + C_GD + ch);
#pragma unroll
            for (int i = 0; i < 16; ++i) {
                const float z0 = bflo(uu[i]), z1 = bfhi(uu[i]);
                float y0 = cw[0][0] * x[0][0] + cw[1][0] * x[1][0] + cw[2][0] * x[2][0] + cw[3][0] * z0;
                float y1 = cw[0][1] * x[0][1] + cw[1][1] * x[1][1] + cw[2][1] * x[2][1] + cw[3][1] * z1;
                x[0][0] = x[1][0]; x[0][1] = x[1][1]; x[1][0] = x[2][0]; x[1][1] = x[2][1]; x[2][0] = z0; x[2][1] = z1;
                y0 = siluf_(y0); y1 = siluf_(y1);
                if (kind < 2) { const float ss = wave_sum(y0 * y0 + y1 * y1); float sc = __builtin_amdgcn_rsqf(ss + 1e-6f); if (kind == 0) sc *= 0.08838834764831845f; y0 *= sc; y1 *= sc;
                    *(unsigned*)(c_GQK + ((size_t)(Rs + i) * 4 + head) * 256 + kind * 128 + 2 * lane) = pk2(y0, y1); }
                else *(unsigned*)(c_GV + (size_t)(Rs + i) * 512 + head * 128 + 2 * lane) = pk2(y0, y1);
            }
        }
        if (tid < 128) { const int tt = tid >> 2, hh = tid & 3; const size_t R = R0 + tt; const float alg = bf2f(Hm[R * HMW + C_GDA + hh]), blg = bf2f(Hm[R * HMW + C_GDB + hh]);
            const float xs = alg + dtb[hh]; const float sp = xs > 20.f ? xs : log1pf(__expf(xs));
            c_GB[(R * 4 + hh) * 2] = __expf(-__expf(alog[hh]) * sp); c_GB[(R * 4 + hh) * 2 + 1] = sigmoidf_(blg); }
    }
}

__device__ __forceinline__ void rwkv_scan(const Ctx& c, int task, int lane, LAS unsigned char* wl) {
    const int rg = lane >> 4, sub = lane & 15;
    const int bh = task >> 4, row = (task & 15) * 4 + rg, bl = bh >> 3, h = bh & 7;
    const unsigned char* gsrc = (const unsigned char*)(c_P6 + ((size_t)bl * SEQ * 8 + h) * 384) + lane * 16;
    bf16* yo = c_Y + (size_t)bl * SEQ * YW + h * 64 + row;
    f32x2 sA = {0.f, 0.f}, sB = {0.f, 0.f};
    u32x4 st[16];
    const bool ld = lane < 48;
    if (ld) {
#pragma unroll
        for (int i = 0; i < 16; ++i) st[i] = *(const u32x4*)(gsrc + (size_t)i * 6144);
#pragma unroll
        for (int i = 0; i < 16; ++i) *(LAS u32x4*)(wl + lane * 16 + i * 768) = st[i];
    }
#pragma unroll 1
    for (int ch = 0; ch < SEQ / 16; ++ch) {
        const int t0 = ch * 16; const bool more = ch + 1 < SEQ / 16;
        LAS unsigned char* rb = wl + (ch & 1) * 12288;
        float yb[16];
        if (ld && more) {
#pragma unroll
            for (int i = 0; i < 16; ++i) st[i] = *(const u32x4*)(gsrc + (size_t)(t0 + 16 + i) * 6144);
        }
        u32x2 nr = *(const LAS u32x2*)(rb + sub * 8), nw = *(const LAS u32x2*)(rb + 128 + sub * 8), nk = *(const LAS u32x2*)(rb + 256 + sub * 8);
        u32x2 nkk = *(const LAS u32x2*)(rb + 512 + sub * 8), nka = *(const LAS u32x2*)(rb + 640 + sub * 8);
        bf16 nv = *(const LAS bf16*)(rb + 384 + row * 2);
        float pyv = 0.f;
#pragma unroll
        for (int i = 0; i < 16; ++i) {
            const u32x2 dr = nr, dw = nw, dk = nk, dkk = nkk, dka = nka; const float v = bf2f(nv);
            if (i + 1 < 16) { LAS unsigned char* q = rb + (i + 1) * 768;
                nr = *(const LAS u32x2*)(q + sub * 8); nw = *(const LAS u32x2*)(q + 128 + sub * 8); nk = *(const LAS u32x2*)(q + 256 + sub * 8);
                nkk = *(const LAS u32x2*)(q + 512 + sub * 8); nka = *(const LAS u32x2*)(q + 640 + sub * 8); nv = *(const LAS bf16*)(q + 384 + row * 2); }
            const f32x2 kk01 = {bflo(dkk.x), bfhi(dkk.x)}, kk23 = {bflo(dkk.y), bfhi(dkk.y)}, w01 = {bflo(dw.x), bfhi(dw.x)}, w23 = {bflo(dw.y), bfhi(dw.y)};
            const f32x2 k01 = {bflo(dk.x), bfhi(dk.x)}, k23 = {bflo(dk.y), bfhi(dk.y)}, ka01 = {bflo(dka.x), bfhi(dka.x)}, ka23 = {bflo(dka.y), bfhi(dka.y)};
            const f32x2 r01 = {bflo(dr.x), bfhi(dr.x)}, r23 = {bflo(dr.y), bfhi(dr.y)};
            const f32x2 p = sA * kk01 + sB * kk23;
            float sk = p.x + p.y, yprev = pyv;
            row_sum16x2(sk, yprev);
            if (i > 0) yb[i - 1] = yprev;
            sA = sA * w01 + (k01 * v - ka01 * sk);
            sB = sB * w23 + (k23 * v - ka23 * sk);
            const f32x2 py = sA * r01 + sB * r23;
            pyv = py.x + py.y;
        }
        yb[15] = row_sum16(pyv);
        if (sub == 0) {
#pragma unroll
            for (int i = 0; i < 16; ++i) yo[(size_t)(t0 + i) * YW] = (bf16)f2bf(yb[i]);
        }
        if (ld && more) {
            LAS unsigned char* wb = wl + ((ch + 1) & 1) * 12288 + lane * 16;
#pragma unroll
            for (int i = 0; i < 16; ++i) *(LAS u32x4*)(wb + i * 768) = st[i];
        }
    }
}
__device__ __forceinline__ void gdn_scan(const Ctx& c, int task, int lane, LAS unsigned char* wl) {
    const int rg = lane >> 4, sub = lane & 15;
    const int bh = task >> 5, cg4 = (task & 31) * 4, col = cg4 + rg, bl = bh >> 2, h = bh & 3;
    const unsigned char* gqk = (const unsigned char*)(c_GQK + ((size_t)bl * SEQ * 4 + h) * 256) + lane * 16;
    const unsigned char* gvb = lane < 16 ? (const unsigned char*)(c_GV + ((size_t)bl * SEQ + lane) * 512 + h * 128 + cg4)
                                         : (const unsigned char*)(c_GB + (((size_t)bl * SEQ + (lane - 16)) * 4 + h) * 2);
    const size_t vstep = lane < 16 ? 1024 : 32;
    bf16* yo = c_Y + (size_t)bl * SEQ * YW + 1024 + h * 128 + col;
    f32x2 g0 = {0.f, 0.f}, g1 = {0.f, 0.f}, g2 = {0.f, 0.f}, g3 = {0.f, 0.f};
    u32x4 st[16]; u32x2 sv;
    const bool ld = lane < 32;
    constexpr int BUF = 8192 + 256;
    if (ld) {
#pragma unroll
        for (int i = 0; i < 16; ++i) st[i] = *(const u32x4*)(gqk + (size_t)i * 2048);
        sv = *(const u32x2*)gvb;
#pragma unroll
        for (int i = 0; i < 16; ++i) *(LAS u32x4*)(wl + lane * 16 + i * 512) = st[i];
        *(LAS u32x2*)(wl + 8192 + lane * 8) = sv;
    }
#pragma unroll 1
    for (int ch = 0; ch < SEQ / 16; ++ch) {
        const int t0 = ch * 16; const bool more = ch + 1 < SEQ / 16;
        LAS unsigned char* rb = wl + (ch & 1) * BUF;
        float yb[16];
        if (ld && more) {
#pragma unroll
            for (int i = 0; i < 16; ++i) st[i] = *(const u32x4*)(gqk + (size_t)(t0 + 16 + i) * 2048);
            sv = *(const u32x2*)(gvb + (size_t)(t0 + 16) * vstep);
        }
        u32x4 nq = *(const LAS u32x4*)(rb + sub * 16), nk = *(const LAS u32x4*)(rb + 256 + sub * 16);
        bf16 nv = *(const LAS bf16*)(rb + 8192 + rg * 2); f32x2 ngb = *(const LAS f32x2*)(rb + 8192 + 128);
        float pov = 0.f;
#pragma unroll
        for (int i = 0; i < 16; ++i) {
            const u32x4 dq = nq, dk = nk; const float v = bf2f(nv); const f32x2 gb = ngb;
            if (i + 1 < 16) { nq = *(const LAS u32x4*)(rb + (i + 1) * 512 + sub * 16); nk = *(const LAS u32x4*)(rb + (i + 1) * 512 + 256 + sub * 16);
                nv = *(const LAS bf16*)(rb + 8192 + (i + 1) * 8 + rg * 2); ngb = *(const LAS f32x2*)(rb + 8192 + 128 + (i + 1) * 8); }
            const f32x2 k01 = {bflo(dk.x), bfhi(dk.x)}, k23 = {bflo(dk.y), bfhi(dk.y)}, k45 = {bflo(dk.z), bfhi(dk.z)}, k67 = {bflo(dk.w), bfhi(dk.w)};
            const f32x2 q01 = {bflo(dq.x), bfhi(dq.x)}, q23 = {bflo(dq.y), bfhi(dq.y)}, q45 = {bflo(dq.z), bfhi(dq.z)}, q67 = {bflo(dq.w), bfhi(dq.w)};
            const float eg = gb.x, beta = gb.y;
            const f32x2 p = (g0 * k01 + g1 * k23) + (g2 * k45 + g3 * k67);
            float ks = p.x + p.y, oprev = pov;
            row_sum16x2(ks, oprev);
            if (i > 0) yb[i - 1] = oprev;
            const float u = beta * (v - eg * ks);
            g0 = g0 * eg + k01 * u; g1 = g1 * eg + k23 * u; g2 = g2 * eg + k45 * u; g3 = g3 * eg + k67 * u;
            const f32x2 po = (g0 * q01 + g1 * q23) + (g2 * q45 + g3 * q67);
            pov = po.x + po.y;
        }
        yb[15] = row_sum16(pov);
        if (sub == 0) {
#pragma unroll
            for (int i = 0; i < 16; ++i) yo[(size_t)(t0 + i) * YW] = (bf16)f2bf(yb[i]);
        }
        if (ld && more) {
            LAS unsigned char* wb = wl + ((ch + 1) & 1) * BUF;
#pragma unroll
            for (int i = 0; i < 16; ++i) *(LAS u32x4*)(wb + lane * 16 + i * 512) = st[i];
            *(LAS u32x2*)(wb + 8192 + lane * 8) = sv;
        }
    }
}
__device__ __forceinline__ void attn_tile(const Ctx& c, int lane, int bh, int qt, float lam, float lam_init, const float* ng) {
    const int qi = lane & 15, g = lane >> 4;
    const int bl = bh >> 2, h = bh & 3, q0 = qt * 16;
    const bf16* Hb = c_Hm + (size_t)bl * SEQ * HMW;
    bf16x8 qf[2][2];
#pragma unroll
    for (int m = 0; m < 2; ++m)
#pragma unroll
        for (int s = 0; s < 2; ++s) qf[m][s] = *(const bf16x8*)(Hb + (size_t)(q0 + qi) * HMW + C_DA + h * 128 + m * 64 + s * 32 + g * 8);
    const bf16* Kb = Hb + C_DAK + h * 128 + g * 8;
    const bf16* Vb = c_Vt + ((size_t)(bl * 4 + h) * 128 + qi) * SEQ + 8 * g;
    const int krow = 8 * (qi >> 2) + (qi & 3);
    f32x4 O[2][8];
#pragma unroll
    for (int m = 0; m < 2; ++m)
#pragma unroll
        for (int d = 0; d < 8; ++d) O[m][d] = (f32x4){0.f, 0.f, 0.f, 0.f};
    float Mx[2] = {-1e30f, -1e30f}, L[2] = {0.f, 0.f};
    const float c1 = 0.125f * 1.4426950408889634f;
    const float c2 = exp2f(-2.0f * (float)(h + 1)) * 1.4426950408889634f;
    const int nb = qt / 2 + 1;
    for (int blk = nb - 1; blk >= 0; --blk) {
        const int kb = blk * 32;
        bf16x8 kf[2][2][2], vf[8];
#pragma unroll
        for (int m = 0; m < 2; ++m)
#pragma unroll
            for (int ta = 0; ta < 2; ++ta)
#pragma unroll
                for (int s = 0; s < 2; ++s) kf[m][ta][s] = *(const bf16x8*)(Kb + (size_t)(kb + krow + 4 * ta) * HMW + m * 64 + s * 32);
#pragma unroll
        for (int d = 0; d < 8; ++d) vf[d] = *(const bf16x8*)(Vb + (size_t)d * 16 * SEQ + kb);
        const int base = kb + 8 * g - (q0 + qi);
        const float fb = c2 * (float)base;
        bf16x8 pf[2];
#pragma unroll
        for (int m = 0; m < 2; ++m) {
            f32x4 S[2];
#pragma unroll
            for (int ta = 0; ta < 2; ++ta) { S[ta] = __builtin_amdgcn_mfma_f32_16x16x32_bf16(kf[m][ta][0], qf[m][0], (f32x4){0.f, 0.f, 0.f, 0.f}, 0, 0, 0); S[ta] = __builtin_amdgcn_mfma_f32_16x16x32_bf16(kf[m][ta][1], qf[m][1], S[ta], 0, 0, 0); }
            float x[8]; float mx = -1e30f;
#pragma unroll
            for (int ta = 0; ta < 2; ++ta)
#pragma unroll
                for (int i = 0; i < 4; ++i) { const int dd = base + 4 * ta + i; float v = S[ta][i] * c1 + (fb + c2 * (float)(4 * ta + i)); v = dd > 0 ? -1e30f : v; x[ta * 4 + i] = v; mx = fmaxf(mx, v); }
            mx = fmaxf(mx, __shfl_xor(mx, 16)); mx = fmaxf(mx, __shfl_xor(mx, 32));
            const float mn = fmaxf(Mx[m], mx), al = __builtin_amdgcn_exp2f(Mx[m] - mn);
            float rs = 0.f;
#pragma unroll
            for (int j = 0; j < 8; ++j) { x[j] = __builtin_amdgcn_exp2f(x[j] - mn); rs += x[j]; }
            if (__builtin_amdgcn_ballot_w64(mn != Mx[m]) != 0ull) {
                L[m] = L[m] * al; Mx[m] = mn;
#pragma unroll
                for (int d = 0; d < 8; ++d) O[m][d] = O[m][d] * al;
            }
            L[m] += rs;
            u32x4 pw; pw.x = pk2(x[0], x[1]); pw.y = pk2(x[2], x[3]); pw.z = pk2(x[4], x[5]); pw.w = pk2(x[6], x[7]);
            pf[m] = __builtin_bit_cast(bf16x8, pw);
        }
#pragma unroll
        for (int d = 0; d < 8; ++d) { O[0][d] = __builtin_amdgcn_mfma_f32_16x16x32_bf16(vf[d], pf[0], O[0][d], 0, 0, 0); O[1][d] = __builtin_amdgcn_mfma_f32_16x16x32_bf16(vf[d], pf[1], O[1][d], 0, 0, 0); }
    }
    float l0 = L[0]; l0 += __shfl_xor(l0, 16); l0 += __shfl_xor(l0, 32);
    float l1 = L[1]; l1 += __shfl_xor(l1, 16); l1 += __shfl_xor(l1, 32);
    const float i0 = 1.0f / l0, i1 = lam / l1;
    float ss = 0.f;
#pragma unroll
    for (int d = 0; d < 8; ++d) { O[0][d] = O[0][d] * i0 - O[1][d] * i1; ss += (O[0][d][0] * O[0][d][0] + O[0][d][1] * O[0][d][1]) + (O[0][d][2] * O[0][d][2] + O[0][d][3] * O[0][d][3]); }
    ss += __shfl_xor(ss, 16); ss += __shfl_xor(ss, 32);
    const float sc = __builtin_amdgcn_rsqf(ss * (1.0f / 128.0f) + 1e-5f) * (1.0f - lam_init);
    bf16* yo = c_Y + (size_t)(bl * SEQ + q0 + qi) * YW + 512 + h * 128 + 4 * g;
#pragma unroll
    for (int d = 0; d < 8; ++d) { const f32x4 gg = *(const f32x4*)(ng + 16 * d + 4 * g); const f32x4 o = O[0][d] * sc * gg; u32x2 w; w.x = pk2(o[0], o[1]); w.y = pk2(o[2], o[3]); *(u32x2*)(yo + 16 * d) = w; }
}
__device__ __forceinline__ void ph_mix(const Ctx& c, int l, int roles) {
    PHASE_IDS();
    if (wave < 2) {
        if (!(roles & 1)) return;
#if !SKIP_RW
        __builtin_amdgcn_s_setprio(3);
        for (int task = c.bid * 2 + wave; task < 512; task += c.G * 2) rwkv_scan(c, task, lane, c.lds + wave * 24576);
        __builtin_amdgcn_s_setprio(0);
#endif
    } else if (wave < 4) {
        if (!(roles & 2)) return;
#if !SKIP_GD
        __builtin_amdgcn_s_setprio(3);
        for (int task = c.bid * 2 + (wave - 2); task < 512; task += c.G * 2) gdn_scan(c, task, lane, c.lds + wave * 24576);
        __builtin_amdgcn_s_setprio(0);
#endif
    } else {
        if (!(roles & 4)) return;
#if !SKIP_DA
        const float lam_init = 0.8f - 0.6f * __expf(-0.3f * (float)l);
        const float d1 = wave_sum(in_ptr(17)[l * 64 + lane] * in_ptr(18)[l * 64 + lane]), d2 = wave_sum(in_ptr(19)[l * 64 + lane] * in_ptr(20)[l * 64 + lane]);
        const float lam = __expf(d1) - __expf(d2) + lam_init;
        const float* ng = in_ptr(21) + l * 128;
        if (wave >= 6) return;
        for (int p = c.bid * 2 + (wave - 4); p < 2048; p += c.G * 2) { const int bh = p >> 7, j = p & 127; attn_tile(c, lane, bh, 255 - j, lam, lam_init, ng); attn_tile(c, lane, bh, j, lam, lam_init, ng); }
#endif
    }
}

__device__ __forceinline__ void ph_post(const Ctx& c, int l) {
    LAS bf16* ACT = (LAS bf16*)c.lds;
    const float* mu = in_ptr(6) + l * 1792; const float* gup = in_ptr(11) + l * 128 * 512;
    const float* lng = in_ptr(15) + l * 512; const float* lnb = in_ptr(16) + l * 512; const float* gng = in_ptr(25) + l * 128;
    PHASE_IDS(); const bf16* Hm = c_Hm; const int h = wave;
    LAS bf16* RES = (LAS bf16*)(c.lds + 16384) + wave * 2048;
    const int mi = lane & 15, g4 = lane >> 4;
    bf16x8 wb[4][4];
#pragma unroll
    for (int nt = 0; nt < 4; ++nt)
#pragma unroll
        for (int ks = 0; ks < 4; ++ks) { const float* W = gup + (size_t)(32 * ks + 8 * g4) * 512 + h * 64 + nt * 16 + mi;
            u32x4 pw; pw.x = pk2(W[0], W[512]); pw.y = pk2(W[1024], W[1536]); pw.z = pk2(W[2048], W[2560]); pw.w = pk2(W[3072], W[3584]); wb[nt][ks] = __builtin_bit_cast(bf16x8, pw); }
    for (int tile = c.bid; tile < MH / 32; tile += c.G) {
        const int R0 = tile * 32, t0 = R0 & (SEQ - 1);
        __syncthreads();
#pragma unroll
        for (int e = tid; e < 32 * 128; e += 512) { const int tt = e >> 7, j = e & 127, col = 1664 + j, R = R0 + tt; const float z = bf2f(Hm[(size_t)R * HMW + col]);
            const float pv = (t0 + tt) > 0 ? bf2f(Hm[(size_t)(R - 1) * HMW + col]) : 0.f; ACT[tt * 136 + j] = (bf16)f2bf(sigmoidf_(z + mu[col] * (pv - z))); }
        __syncthreads();
#pragma unroll
        for (int mt = 0; mt < 2; ++mt) {
            bf16x8 af[4];
#pragma unroll
            for (int ks = 0; ks < 4; ++ks) af[ks] = *(const LAS bf16x8*)(ACT + (mt * 16 + mi) * 136 + 32 * ks + 8 * g4);
#pragma unroll
            for (int nt = 0; nt < 4; ++nt) {
                f32x4 d = (f32x4){0.f, 0.f, 0.f, 0.f};
#pragma unroll
                for (int ks = 0; ks < 4; ++ks) d = __builtin_amdgcn_mfma_f32_16x16x32_bf16(af[ks], wb[nt][ks], d, 0, 0, 0);
#pragma unroll
                for (int i = 0; i < 4; ++i) RES[(mt * 16 + 4 * g4 + i) * 64 + nt * 16 + mi] = (bf16)f2bf(d[i]);
            }
        }
        {
            const float muv = mu[1024 + tid], lg = lng[tid], lb = lnb[tid];
            float pvv = 0.f; if (t0 > 0) pvv = bf2f(Hm[(size_t)(R0 - 1) * HMW + 1024 + tid]);
#pragma unroll 1
            for (int tg = 0; tg < 4; ++tg) {
                bf16 y8[8], zv8[8]; float bn8[8];
#pragma unroll
                for (int u = 0; u < 8; ++u) { const size_t R = R0 + tg * 8 + u; y8[u] = c_Y[R * YW + tid]; zv8[u] = Hm[R * HMW + 1024 + tid]; bn8[u] = c_BON[R * 8 + h]; }
#pragma unroll
                for (int u = 0; u < 8; ++u) {
                    const int tt = tg * 8 + u;
                    const float acc = bf2f(RES[tt * 64 + lane]);
                    const size_t R = R0 + tt;
                    const float y = bf2f(y8[u]);
                    const float mean = wave_sum(y) * (1.0f / 64.0f), d = y - mean, var = wave_sum(d * d) * (1.0f / 64.0f);
                    const float yn = d * __builtin_amdgcn_rsqf(var + 64e-5f) * lg + lb;
                    const float zv = bf2f(zv8[u]); const float v = zv + muv * (pvv - zv); pvv = zv;
                    float o = (yn + bn8[u] * v) * acc;
#if SKIP_RW
                    o = 0.f;
#endif
                    c_Y[R * YW + tid] = (bf16)f2bf(o);
                }
            }
        }
        {
            unsigned yu[4][4], zz[4][4];
#pragma unroll
            for (int a = 0; a < 4; ++a)
#pragma unroll
                for (int hh = 0; hh < 4; ++hh) { const size_t R = R0 + wave + 8 * a; yu[a][hh] = *(const unsigned*)(c_Y + R * YW + 1024 + hh * 128 + 2 * lane); zz[a][hh] = *(const unsigned*)(Hm + R * HMW + C_GDZ + hh * 128 + 2 * lane); }
            const float gn0 = gng[2 * lane], gn1 = gng[2 * lane + 1];
#pragma unroll
            for (int a = 0; a < 4; ++a) {
                const size_t R = R0 + wave + 8 * a;
#pragma unroll
                for (int hh = 0; hh < 4; ++hh) {
                    const float o0 = bflo(yu[a][hh]), o1 = bfhi(yu[a][hh]);
                    const float ss = wave_sum(o0 * o0 + o1 * o1) * (1.0f / 128.0f), sc = __builtin_amdgcn_rsqf(ss + 1e-6f);
                    float r0 = o0 * sc * gn0 * siluf_(bflo(zz[a][hh])), r1 = o1 * sc * gn1 * siluf_(bfhi(zz[a][hh]));
#if SKIP_GD
                    r0 = 0.f; r1 = 0.f;
#endif
                    *(unsigned*)(c_Y + R * YW + 1024 + hh * 128 + 2 * lane) = pk2(r0, r1);
                }
#if SKIP_DA
                for (int e = lane; e < 256; e += 64) *(unsigned*)(c_Y + R * YW + 512 + 2 * e) = 0u;
#endif
            }
        }
    }
}

constexpr int PH_PER_LAYER = 20;
__global__ void __launch_bounds__(NWAVES * 64, 2) fwd_kernel(Params p) {
    extern __shared__ __attribute__((aligned(16))) unsigned char lds_raw[];
    cg::grid_group grid = cg::this_grid();
    if (p.ph_hi < 0) grid.sync();
    Ctx c;
    c.lds = (LAS unsigned char*)lds_raw; c.wv = __builtin_amdgcn_readfirstlane(threadIdx.x >> 6); c.G = gridDim.x; c.bid = blockIdx.x;
    c.X = p.out; c.ws = p.ws;
    volatile LAS unsigned* bst = (volatile LAS unsigned*)(c.lds + 131072 + 512);
    { const int t_ = threadIdx.x; if (t_ < 2) bst[t_] = 0u; }
    __syncthreads();
    const XcdBarrier bar = xcd_barrier_post((unsigned*)(p.ws + WS_BAR), bst);
    for (int ph = p.ph_lo; ph < p.ph_hi; ++ph) {
        const int l = ph / PH_PER_LAYER, k = ph % PH_PER_LAYER;
        pg8::TileOrder S;
#ifndef PHMASK
#define PHMASK 255
#endif
        if (k == 0 && l > 0) continue;
        const int wl = (l == 0 && (k == 0 || k == 19)) ? (k == 0 ? 0 : 1) : -1;
        if (k == 0) ph_x_to_bf16(c);
        else if (k == 1 || k == 17) {
            pg8::Gemm g{c_XN, c_W + (k == 1 ? W_1 : W_3), DM, DM}; S.init(MTOK, 2 * DFF, c.G, c.bid, 1);
            pg8::EpiSwiglu E{c_HB}; pg8::gemm_phase(c.lds, g, S, E, c.wv);
        } else if (k == 2 || k == 18) {
            pg8::Gemm g{c_HB, c_W + (k == 2 ? W_2 : W_4), DFF, DFF}; S.init(MTOK, DM, c.G, c.bid, 1);
            pg8::EpiResid E{(l == 0 && k == 2) ? in_ptr(0) : c.X, c.X, ALPHA, 0.5f}; pg8::gemm_phase(c.lds, g, S, E, c.wv);
        } else if (k == 3) ph_ln(c, in_ptr(3) + l * DM, in_ptr(4) + l * DM);
        else if (k == 16) ph_ln(c, in_ptr(28) + l * DM, in_ptr(29) + l * DM);
        else if (k == 19) ph_ln(c, in_ptr(32) + l * DM, in_ptr(33) + l * DM);
        else {
            const int hb = (k - 4) / 6, kk = (k - 4) % 6;
            const bf16* XNh = c_XN + (size_t)hb * MH * DM; float* Xh = c.X + (size_t)hb * MH * DM;
#if SKIP_MIX
            if (kk == 5) { pg8::Gemm g{XNh, c_W + W_O, DM, DM}; S.init(MH, DM, c.G, c.bid, 1); pg8::EpiResid E{Xh, Xh, ALPHA, 0.0f}; pg8::gemm_phase(c.lds, g, S, E, c.wv); }
#else
            if (kk == 0) { pg8::Gemm g{XNh, c_W + W_M, DM, DM}; S.init(MH, HMW, c.G, c.bid, 1); pg8::EpiHm E{c_Hm, c_Vt, HMW, 11}; pg8::gemm_phase(c.lds, g, S, E, c.wv); }
            else if (kk == 1) { if (PHMASK & 2) { ph_prep(c, l);
#ifdef REPEAT_PREP
                ph_prep(c, l);
#endif
            } }
            else if (kk == 2) { if (PHMASK & 4) { ph_mix(c, l, 7);
#ifdef REPEAT_MIX
                ph_mix(c, l, REPEAT_MIX);
#endif
            } }
            else if (kk == 3) { if (PHMASK & 8) ph_post(c, l);
                __syncthreads();
                pg8::Gemm g{XNh, c_W + W_G, DM, DM}; S.init(MH, HGW, c.G, c.bid, 1); pg8::EpiHm E{c_Hg, c_Vt, HGW, 1 << 20}; pg8::gemm_phase(c.lds, g, S, E, c.wv); }
            else if (kk == 4) { pg8::Gemm g{c_Y, c_W + W_B, YW, 512}; S.init(MH, DM, c.G, c.bid, 3); pg8::EpiMerge E{c_Hg, c_Mg}; pg8::gemm_phase(c.lds, g, S, E, c.wv); }
            else { pg8::Gemm g{c_Mg, c_W + W_O, DM, DM}; S.init(MH, DM, c.G, c.bid, 1); pg8::EpiResid E{Xh, Xh, ALPHA, 1.0f}; pg8::gemm_phase<pg8::EpiResid, 16>(c.lds, g, S, E, c.wv); }
#endif
        }
        if (wl >= 0) ph_weights(c, wl);
        if (ph + 1 < p.ph_hi || DBG_DUMP) {
#if USE_CG_SYNC
            __builtin_amdgcn_fence(__ATOMIC_RELEASE, "agent"); asm volatile("s_waitcnt vmcnt(0) lgkmcnt(0)" ::: "memory");
            grid.sync();
            __builtin_amdgcn_fence(__ATOMIC_ACQUIRE, "agent"); asm volatile("s_waitcnt vmcnt(0)" ::: "memory");
#else
            xcd_barrier(bar, c.wv);
#endif
        }
    }
#if DBG_DUMP
    {
        const bf16* src = (const bf16*)(p.ws + DBG_SRC);
        const size_t n = (size_t)DBG_N, tot = (size_t)MTOK * DM;
        for (size_t i = (size_t)blockIdx.x * 512 + threadIdx.x; i < tot; i += (size_t)gridDim.x * 512) p.out[i] = i < n ? bf2f(src[i]) : 0.f;
    }
#endif
}

extern "C" void kernel_launch(void* const* d_in, const int* in_sizes, int n_in, void* d_out, int out_size, void* d_ws, size_t ws_size, hipStream_t stream) {
    static int grid = 0;
    if (grid == 0) {
        if (n_in != 34 || out_size != MTOK * DM || ws_size < WS_END) { fprintf(stderr, "kernel_launch: unexpected problem (n_in %d out %d ws %zu)\n", n_in, out_size, ws_size); grid = -1; return; }
        int dev = 0, cus = 0, per_cu = 0;
        hipGetDevice(&dev); hipDeviceGetAttribute(&cus, hipDeviceAttributeMultiprocessorCount, dev);
        hipFuncSetAttribute((const void*)fwd_kernel, hipFuncAttributeMaxDynamicSharedMemorySize, LDS_BYTES);
        hipOccupancyMaxActiveBlocksPerMultiprocessor(&per_cu, (const void*)fwd_kernel, NWAVES * 64, LDS_BYTES);
        if (per_cu < 1) per_cu = 1;
        grid = cus * per_cu; if (grid > 256) grid = 256;
        (void)hipGetLastError();
    }
    if (grid < 0) return;
    if (hipMemsetAsync((char*)d_ws + WS_BAR, 0, XCD_BAR_WORDS * 4, stream) != hipSuccess) { fprintf(stderr, "memset failed\n"); return; }
    Params p{};
    for (int i = 0; i < 34; ++i) p.in[i] = (const float*)d_in[i];
    p.out = (float*)d_out; p.ws = (unsigned char*)d_ws; p.ph_lo = 0; p.ph_hi = DBG_HI;
    void* args[] = {&p};
    hipError_t e = hipLaunchCooperativeKernel((const void*)fwd_kernel, dim3(grid), dim3(NWAVES * 64), args, LDS_BYTES, stream);
    if (e != hipSuccess) fprintf(stderr, "cooperative launch failed: %s (grid %d)\n", hipGetErrorString(e), grid);
}
```

```cpp
#include <hip/hip_runtime.h>
#include <hip/hip_cooperative_groups.h>
#include <cstdio>
#include <cstdint>
namespace cg = cooperative_groups;

#define LAS __attribute__((address_space(3)))
typedef unsigned short bf16;
typedef short bf16x8 __attribute__((ext_vector_type(8)));
typedef float f32x4 __attribute__((ext_vector_type(4)));
typedef float f32x2 __attribute__((ext_vector_type(2)));
typedef unsigned u32x4 __attribute__((ext_vector_type(4)));
typedef unsigned u32x2 __attribute__((ext_vector_type(2)));

#ifndef USE_CG_SYNC
#define USE_CG_SYNC 0
#endif
#ifndef DBG_DUMP
#define DBG_DUMP 0
#define DBG_SRC 0
#define DBG_N 0
#define DBG_HI (2 * PH_PER_LAYER)
#endif
#ifndef SKIP_RW
#define SKIP_RW 0
#endif
#ifndef SKIP_DA
#define SKIP_DA 0
#endif
#ifndef SKIP_GD
#define SKIP_GD 0
#endif
#ifndef SKIP_MIX
#define SKIP_MIX 0
#endif

constexpr int MTOK = 32768, MH = 16384, DM = 1024, DFF = 2816, SEQ = 4096;
constexpr int HMW = 5632;
constexpr int HGW = 3072;
constexpr int YW = 1536;
constexpr int NWAVES = 8;
constexpr int LDS_BYTES = 131072 + 1024;
constexpr float ALPHA = 1.41421356237f;

constexpr int C_RW = 0, C_DA = 1792, C_DAK = 2304, C_DAV = 2816, C_GD = 3328, C_GDA = 4864, C_GDB = 4868, C_GDZ = 4872;

constexpr size_t MiB = 1u << 20;
constexpr size_t WS_BON = 0;
constexpr size_t WS_GB = 1 * MiB;
constexpr size_t WS_BAR = 2 * MiB;
constexpr size_t WS_W = 4 * MiB;
constexpr size_t WS_XN = 60 * MiB;
constexpr size_t WS_A = 124 * MiB;
constexpr size_t WS_B = 300 * MiB;
constexpr size_t WS_P6 = WS_B, WS_GQK = WS_B + 96 * MiB, WS_GV = WS_B + 128 * MiB, WS_VT = WS_B + 144 * MiB;
constexpr size_t WS_C = 460 * MiB;
constexpr size_t WS_END = 508 * MiB;
constexpr size_t W_1 = 0, W_2 = 5767168, W_M = 8650752, W_G = 14417920, W_B = 17563648, W_O = 19136512, W_3 = 20185088, W_4 = 25952256;

__device__ __forceinline__ float bf2f(bf16 b) { return __uint_as_float((unsigned)b << 16); }
__device__ __forceinline__ float bflo(unsigned u) { return __uint_as_float(u << 16); }
__device__ __forceinline__ float bfhi(unsigned u) { return __uint_as_float(u & 0xffff0000u); }
typedef __bf16 bf16x2_t __attribute__((ext_vector_type(2)));
__device__ __forceinline__ unsigned pk2(float lo, float hi) { const f32x2 v = {lo, hi}; const bf16x2_t b = __builtin_convertvector(v, bf16x2_t); return __builtin_bit_cast(unsigned, b); }
__device__ __forceinline__ unsigned f2bf(float f) { return pk2(f, f) & 0xffffu; }
__device__ __forceinline__ float sigmoidf_(float x) { return __builtin_amdgcn_rcpf(1.0f + __expf(-x)); }
__device__ __forceinline__ float siluf_(float x) { return x * sigmoidf_(x); }
__device__ __forceinline__ float tanhf_(float x) { return 1.0f - 2.0f * __builtin_amdgcn_rcpf(__expf(2.0f * x) + 1.0f); }
template <int CTRL> __device__ __forceinline__ float dppf(float x) { return __int_as_float(__builtin_amdgcn_update_dpp(0, __float_as_int(x), CTRL, 0xf, 0xf, false)); }
__device__ __forceinline__ float row_sum16(float x) {
    x += dppf<0x128>(x); x += dppf<0x124>(x); x += dppf<0x122>(x); x += dppf<0x121>(x); return x;
}


#define XB_TMO      128
#define XB_XCNT(j)  (256  + 64 * (j))
#define XB_XSUB(j)  (1280 + 64 * (j))
#define XB_XGEN(j)  (2304 + 64 * (j))
#define XB_TOP      3328
#define XB_TOPGEN   3392
#define XCD_BAR_WORDS 3456
#define XB_SPIN_CAP (1u << 22)
__device__ __forceinline__ unsigned xb_ld(unsigned* p)              { return __hip_atomic_load(p, __ATOMIC_RELAXED, __HIP_MEMORY_SCOPE_AGENT); }
__device__ __forceinline__ unsigned xb_add(unsigned* p, unsigned v) { return __hip_atomic_fetch_add(p, v, __ATOMIC_RELAXED, __HIP_MEMORY_SCOPE_AGENT); }
__device__ __forceinline__ unsigned xb_xcc_id() { return (unsigned)__builtin_amdgcn_s_getreg((3 << 11) | 20) & 0xFu; }
#define XB_SPIN(cond, bar) do { unsigned _sp = 0; while (cond) { __builtin_amdgcn_s_sleep(1); \
    if ((++_sp & 255u) == 0u) { if (xb_ld(&(bar)[XB_TMO])) break; if (_sp > XB_SPIN_CAP) { atomicAdd(&(bar)[XB_TMO], 1u); break; } } } } while (0)
struct XcdBarrier { unsigned* bar; unsigned x; volatile LAS unsigned* st; };
__device__ __forceinline__ XcdBarrier xcd_barrier_post(unsigned* bar, volatile LAS unsigned* st) {
    XcdBarrier b; b.bar = bar; b.x = xb_xcc_id(); b.st = st;
    if (threadIdx.x == 0) (void)xb_add(&bar[XB_XCNT(b.x)], 1u);
    return b;
}
__device__ __forceinline__ void xcd_barrier_complete(unsigned* bar, unsigned x, unsigned& nloc, unsigned& nx) {
    const unsigned G = gridDim.x * gridDim.y * gridDim.z;
    unsigned sum, cnt, mine, sp = 0u;
    for (;;) {
        sum = 0u; cnt = 0u; mine = 0u;
#pragma unroll
        for (unsigned j = 0; j < 16; ++j) { const unsigned c = xb_ld(&bar[XB_XCNT(j)]); sum += c; cnt += (c > 0u) ? 1u : 0u; mine = (j == x) ? c : mine; }
        if (sum == G) break;
        __builtin_amdgcn_s_sleep(1);
        if ((++sp & 255u) == 0u) { if (xb_ld(&bar[XB_TMO])) break; if (sp > XB_SPIN_CAP) { atomicAdd(&bar[XB_TMO], 1u); break; } }
    }
    nloc = mine > 0u ? mine : 1u; nx = cnt > 0u ? cnt : 1u;
}
__device__ __forceinline__ void xcd_barrier(const XcdBarrier& b, const int wv) {
    asm volatile("s_waitcnt vmcnt(0)" ::: "memory");
    __syncthreads();
    if (wv == 0 && __builtin_amdgcn_mbcnt_hi(~0u, __builtin_amdgcn_mbcnt_lo(~0u, 0u)) == 0u) {
        unsigned* bar = b.bar;
        __builtin_amdgcn_s_waitcnt(0);
        unsigned nloc = b.st[0], nx = b.st[1];
        if (nloc == 0u) { xcd_barrier_complete(bar, b.x, nloc, nx); b.st[0] = nloc; b.st[1] = nx; }
        const unsigned old = xb_add(&bar[XB_XSUB(b.x)], 1u);
        const unsigned gen = old / nloc;
        if (old + 1u == (gen + 1u) * nloc) {
            __builtin_amdgcn_fence(__ATOMIC_RELEASE, "agent");
            asm volatile("s_waitcnt vmcnt(0)" ::: "memory");
            const unsigned og = xb_add(&bar[XB_TOP], 1u);
            const unsigned tg = og / nx;
            if (og + 1u == (tg + 1u) * nx) xb_add(&bar[XB_TOPGEN], 1u);
            else XB_SPIN(xb_ld(&bar[XB_TOPGEN]) == tg, bar);
            __builtin_amdgcn_fence(__ATOMIC_ACQUIRE, "agent");
            xb_add(&bar[XB_XGEN(b.x)], 1u);
            asm volatile("s_waitcnt vmcnt(0)" ::: "memory");
        } else {
            XB_SPIN(xb_ld(&bar[XB_XGEN(b.x)]) == gen, bar);
            __builtin_amdgcn_fence(__ATOMIC_ACQUIRE, "agent");
            asm volatile("s_waitcnt vmcnt(0)" ::: "memory");
        }
    }
    __syncthreads();
}

__device__ __forceinline__ void row_sum16x2(float& a, float& b) {
    a += dppf<0x128>(a); b += dppf<0x128>(b); a += dppf<0x124>(a); b += dppf<0x124>(b); a += dppf<0x122>(a); b += dppf<0x122>(b); a += dppf<0x121>(a); b += dppf<0x121>(b);
}
__device__ __forceinline__ float wave_sum(float v) {
    v = row_sum16(v);
    const int iv = __float_as_int(v);
    return (__int_as_float(__builtin_amdgcn_readlane(iv, 0)) + __int_as_float(__builtin_amdgcn_readlane(iv, 16))) + (__int_as_float(__builtin_amdgcn_readlane(iv, 32)) + __int_as_float(__builtin_amdgcn_readlane(iv, 48)));
}
namespace pg8 {
constexpr int BM = 256, BK = 64, HALF = 128, HTB = HALF * BK * 2, STAGE_BYTES = 8 * HTB, NXCD = 8, WGM = 8;
__host__ __device__ __forceinline__ int lds_byte(int r, int c) { const int st = (r >> 4) * 2 + (c >> 5), rr = r & 15, cc = c & 31, ob = rr * 64 + cc * 2; return st * 1024 + (ob ^ (((ob >> 9) & 1) << 5)); }
__host__ __device__ __forceinline__ void stage_rc(int b, int& R, int& C) { const int st = b / 1024, sb = b % 1024, swz = sb ^ (((sb >> 9) & 1) << 5); R = (st >> 1) * 16 + swz / 64; C = (st & 1) * 32 + (swz % 64) / 2; }
__host__ __device__ __forceinline__ int perm32(int rho) { const int n = rho >> 4, i = rho & 15; return 8 * (i >> 2) + 4 * n + (i & 3); }

struct Unit { int pm, pn, aofs, tag; };
struct Gemm { const bf16* A; const bf16* Bt; int lda, K; };

struct TileOrder {
    int nM, nN, nwg, G, c, nbr, sw;
    __device__ void init(int M, int N, int G_, int c_, int nbr_) { nM = M / BM; nN = N / BM; nwg = nM * nN; G = G_; c = c_; nbr = nbr_; sw = 0; }
    __device__ bool next(int i, Unit& u) const {
        const int it = i / nbr, br = i - it * nbr;
        const long L = (long)it * G + c; if (L >= nwg) return false;
        int wgid = (int)L; { const int q = nwg / NXCD, r = nwg % NXCD, xcd = wgid % NXCD, off = wgid / NXCD; wgid = (xcd < r ? xcd * (q + 1) : r * (q + 1) + (xcd - r) * q) + off; }
        const int nig = WGM * nN, gid = wgid / nig, fm = gid * WGM, gsz = (nM - fm) < WGM ? (nM - fm) : WGM;
        u.pm = fm + ((wgid % nig) % gsz); int pn = (wgid % nig) / gsz; if (sw) pn = pn == 12 ? 14 : (pn == 14 ? 12 : pn);
        u.pn = pn + br * nN; u.aofs = br * 1024; u.tag = br; return true;
    }
};

template <class Epi, int A_AUX = 0>
__device__ __forceinline__ void gemm_phase(LAS unsigned char* lds, const Gemm g, const TileOrder& S, const Epi& E, const int wid) {
    int lane = (int)__builtin_amdgcn_mbcnt_hi(~0u, __builtin_amdgcn_mbcnt_lo(~0u, 0u)); asm volatile("" : "+v"(lane));
    const int tid = wid * 64 + lane, wr = wid >> 2, wc = wid & 3, fr = lane & 15, fq = lane >> 4;
    const int K = g.K, nt = K / BK, lda = g.lda;
    unsigned voffA[2], voffB[2];
#pragma unroll
    for (int i = 0; i < 2; ++i) { int R, C; stage_rc(tid * 16 + i * 8192, R, C); const int Rb = Epi::PERM ? ((R & ~31) + perm32(R & 31)) : R;
        voffA[i] = (unsigned)(R * lda + C) * 2u; voffB[i] = (unsigned)(Rb * K + C) * 2u; }
    const size_t kstep = (size_t)(BK * 2);
    const size_t hstepA = (size_t)HALF * lda * 2, hstepB = (size_t)HALF * K * 2;
    const size_t tstepA = 2 * hstepA, tstepB = 2 * hstepB;
    const unsigned ldsw = (unsigned)wid * 1024u;
    const int aoff = lds_byte(wr * 64 + fr, fq * 8), boff = lds_byte(wc * 32 + fr, fq * 8);
#define PG8_SA(b, h) (((b) * 2 + (h)) * HTB)
#define PG8_SB(b, h) ((4 + (b) * 2 + (h)) * HTB)
#define PG8_STAGE_X(bufoff, gbase, voff, AUX) do { _Pragma("unroll") for (int _i = 0; _i < 2; ++_i) \
        __builtin_amdgcn_global_load_lds((const unsigned*)((const char*)(gbase) + (voff)[_i]), (LAS unsigned*)(lds + (bufoff) + ldsw + _i * 8192), 16, 0, AUX); } while (0)
#define PG8_STAGE(bufoff, gbase, voff) PG8_STAGE_X(bufoff, gbase, voff, 0)
#define PG8_STAGEA(bufoff, gbase, voff) PG8_STAGE_X(bufoff, gbase, voff, A_AUX)
#define PG8_LDA(dst, b, h) do { _Pragma("unroll") for (int m = 0; m < 4; ++m) _Pragma("unroll") for (int k = 0; k < 2; ++k) dst[m][k] = *(const LAS bf16x8*)(lds + PG8_SA(b, h) + aoff + m * 2048 + k * 1024); } while (0)
#define PG8_LDB(dst, b, h) do { _Pragma("unroll") for (int n = 0; n < 2; ++n) _Pragma("unroll") for (int k = 0; k < 2; ++k) dst[n][k] = *(const LAS bf16x8*)(lds + PG8_SB(b, h) + boff + n * 2048 + k * 1024); } while (0)
#define PG8_MMA(ai, bj, At, Bt) do { __builtin_amdgcn_s_setprio(1); _Pragma("unroll") for (int m = 0; m < 4; ++m) _Pragma("unroll") for (int n = 0; n < 2; ++n) _Pragma("unroll") for (int k = 0; k < 2; ++k) \
        acc[ai][bj][m][n] = __builtin_amdgcn_mfma_f32_16x16x32_bf16(Bt[n][k], At[m][k], acc[ai][bj][m][n], 0, 0, 0); __builtin_amdgcn_s_setprio(0); } while (0)
#define PG8_WAIT_V(n) asm volatile("s_waitcnt vmcnt(" #n ")" ::: "memory")
#define PG8_WAIT_L(n) asm volatile("s_waitcnt lgkmcnt(" #n ")" ::: "memory")
#define PG8_BAR __builtin_amdgcn_s_barrier()
#define PG8_SCHED __builtin_amdgcn_sched_barrier(0)
    Unit cur, nxt; int ui = 0;
    if (!S.next(0, cur)) return;
    f32x4 acc[2][2][4][2];
#pragma unroll
    for (int a = 0; a < 2; ++a)
#pragma unroll
        for (int b = 0; b < 2; ++b)
#pragma unroll
            for (int m = 0; m < 4; ++m)
#pragma unroll
                for (int n = 0; n < 2; ++n) acc[a][b][m][n] = (f32x4){0.f, 0.f, 0.f, 0.f};
    bf16x8 At[4][2], B0[2][2], B1[2][2];
    const char* cA = (const char*)g.A + (size_t)cur.pm * tstepA + cur.aofs; const char* cB = (const char*)g.Bt + (size_t)cur.pn * tstepB;
    {
        PG8_STAGE(PG8_SB(0, 0), cB, voffB); PG8_STAGE(PG8_SB(0, 1), cB + hstepB, voffB); PG8_STAGEA(PG8_SA(0, 0), cA, voffA); PG8_STAGEA(PG8_SA(0, 1), cA + hstepA, voffA);
        if (wr == 1) PG8_BAR;
        PG8_WAIT_V(2); PG8_BAR;
        PG8_STAGE(PG8_SB(1, 0), cB + kstep, voffB); PG8_STAGEA(PG8_SA(1, 0), cA + kstep, voffA); PG8_STAGE(PG8_SB(1, 1), cB + hstepB + kstep, voffB);
        PG8_WAIT_V(6); PG8_BAR;
    }
    for (;;) {
        const bool has_next = S.next(ui + 1, nxt);
        const char* nA = has_next ? (const char*)g.A + (size_t)nxt.pm * tstepA + nxt.aofs : cA; const char* nB = has_next ? (const char*)g.Bt + (size_t)nxt.pn * tstepB : cB;
        for (int t = 0; t < nt; t += 2) {
            const bool last = (t == nt - 2);
            const char* a1 = cA + (size_t)(t + 1) * kstep;
            const char* a2 = last ? nA : cA + (size_t)(t + 2) * kstep; const char* b2 = last ? nB : cB + (size_t)(t + 2) * kstep;
            const char* a3 = a2 + kstep; const char* b3 = b2 + kstep;
            PG8_LDB(B0, 0, 0); PG8_LDB(B1, 0, 1); PG8_SCHED; PG8_LDA(At, 0, 0); PG8_STAGEA(PG8_SA(1, 1), a1 + hstepA, voffA);
            PG8_WAIT_V(8); PG8_WAIT_L(0); PG8_BAR; PG8_MMA(0, 0, At, B0); PG8_MMA(0, 1, At, B1); PG8_BAR; PG8_SCHED;
            PG8_LDA(At, 0, 1); PG8_STAGE(PG8_SB(0, 0), b2, voffB); PG8_STAGE(PG8_SB(0, 1), b2 + hstepB, voffB); PG8_STAGEA(PG8_SA(0, 0), a2, voffA);
            PG8_WAIT_V(8); PG8_WAIT_L(0); PG8_BAR; PG8_MMA(1, 0, At, B0); PG8_MMA(1, 1, At, B1); PG8_BAR; PG8_SCHED;
            PG8_LDB(B0, 1, 0); PG8_LDB(B1, 1, 1); PG8_SCHED; PG8_LDA(At, 1, 0); PG8_STAGEA(PG8_SA(0, 1), a2 + hstepA, voffA);
            PG8_WAIT_V(8); PG8_WAIT_L(0); PG8_BAR; PG8_MMA(0, 0, At, B0); PG8_MMA(0, 1, At, B1); PG8_BAR; PG8_SCHED;
            PG8_LDA(At, 1, 1); PG8_STAGE(PG8_SB(1, 0), b3, voffB); PG8_STAGE(PG8_SB(1, 1), b3 + hstepB, voffB); PG8_STAGEA(PG8_SA(1, 0), a3, voffA);
            PG8_WAIT_V(8); PG8_WAIT_L(0); PG8_BAR; PG8_MMA(1, 0, At, B0); PG8_MMA(1, 1, At, B1); PG8_BAR; PG8_SCHED;
        }
        if (wr == 0) PG8_BAR;
        E(acc, cur, wr, wc, fr, fq);
        if (!has_next) break;
#pragma unroll
        for (int a = 0; a < 2; ++a)
#pragma unroll
            for (int b = 0; b < 2; ++b)
#pragma unroll
                for (int m = 0; m < 4; ++m)
#pragma unroll
                    for (int n = 0; n < 2; ++n) acc[a][b][m][n] = (f32x4){0.f, 0.f, 0.f, 0.f};
        cur = nxt; cA = nA; cB = nB; ++ui;
        if (wr == 1) PG8_BAR;
    }
    PG8_WAIT_V(0);
    PG8_BAR;
#undef PG8_SA
#undef PG8_SB
#undef PG8_STAGE
#undef PG8_STAGEA
#undef PG8_STAGE_X
#undef PG8_LDA
#undef PG8_LDB
#undef PG8_MMA
#undef PG8_WAIT_V
#undef PG8_WAIT_L
#undef PG8_BAR
#undef PG8_SCHED
}

typedef f32x4 Acc[2][2][4][2];

struct EpiSwiglu {
    static constexpr bool PERM = true; bf16* O;
    __device__ __forceinline__ void operator()(const Acc& acc, const Unit& u, int wr, int wc, int fr, int fq) const {
        const int row0 = u.pm * BM + wr * 64 + fr, col0 = u.pn * 128 + wc * 32 + 8 * fq;
#pragma unroll
        for (int ai = 0; ai < 2; ++ai)
#pragma unroll
            for (int m = 0; m < 4; ++m) {
                bf16* rowp = O + (size_t)(row0 + ai * HALF + m * 16) * DFF + col0;
                const f32x4 g0 = acc[ai][0][m][0], g1 = acc[ai][0][m][1], u0 = acc[ai][1][m][0], u1 = acc[ai][1][m][1];
                u32x4 w;
                w.x = pk2(siluf_(g0[0]) * u0[0], siluf_(g0[1]) * u0[1]); w.y = pk2(siluf_(g0[2]) * u0[2], siluf_(g0[3]) * u0[3]);
                w.z = pk2(siluf_(g1[0]) * u1[0], siluf_(g1[1]) * u1[1]); w.w = pk2(siluf_(g1[2]) * u1[2], siluf_(g1[3]) * u1[3]);
                *(u32x4*)rowp = w;
            }
    }
};
struct EpiResid {
    static constexpr bool PERM = false; const float* base; float* out; float alpha, s;
    __device__ __forceinline__ void operator()(const Acc& acc, const Unit& u, int wr, int wc, int fr, int fq) const {
        const int col0 = u.pn * BM + wc * 32 + 4 * fq;
#pragma unroll
        for (int ai = 0; ai < 2; ++ai)
#pragma unroll
            for (int m = 0; m < 4; ++m) {
                const size_t off = (size_t)(u.pm * BM + ai * HALF + wr * 64 + m * 16 + fr) * DM + col0;
#pragma unroll
                for (int bj = 0; bj < 2; ++bj)
#pragma unroll
                    for (int n = 0; n < 2; ++n) { const f32x4 b = *(const f32x4*)(base + off + bj * HALF + n * 16); *(f32x4*)(out + off + bj * HALF + n * 16) = b * alpha + acc[ai][bj][m][n] * s; }
            }
    }
};
struct EpiHm {
    static constexpr bool PERM = true; bf16* O; bf16* Vt; int ldc, vlo;
    __device__ __forceinline__ void operator()(const Acc& acc, const Unit& u, int wr, int wc, int fr, int fq) const {
        const int row0 = u.pm * BM + wr * 64 + fr;
        if (u.pn == vlo || u.pn == vlo + 1) {
#pragma unroll
            for (int ai = 0; ai < 2; ++ai)
#pragma unroll
                for (int m = 0; m < 4; ++m) {
                    const int r = row0 + ai * HALF + m * 16, bl = r >> 12, t = r & 4095;
#pragma unroll
                    for (int bj = 0; bj < 2; ++bj)
#pragma unroll
                        for (int n = 0; n < 2; ++n)
#pragma unroll
                            for (int e = 0; e < 4; ++e) {
                                const int cv = (u.pn - vlo) * 256 + bj * HALF + wc * 32 + 8 * fq + 4 * n + e;
                                Vt[((size_t)(bl * 4 + (cv >> 7)) * 128 + (cv & 127)) * SEQ + t] = (bf16)f2bf(acc[ai][bj][m][n][e]);
                            }
                }
            return;
        }
        const int col0 = u.pn * BM + wc * 32 + 8 * fq;
#pragma unroll
        for (int ai = 0; ai < 2; ++ai)
#pragma unroll
            for (int m = 0; m < 4; ++m) {
                bf16* rowp = O + (size_t)(row0 + ai * HALF + m * 16) * ldc + col0;
#pragma unroll
                for (int bj = 0; bj < 2; ++bj) { const f32x4 v0 = acc[ai][bj][m][0], v1 = acc[ai][bj][m][1]; u32x4 w; w.x = pk2(v0[0], v0[1]); w.y = pk2(v0[2], v0[3]); w.z = pk2(v1[0], v1[1]); w.w = pk2(v1[2], v1[3]); *(u32x4*)(rowp + bj * HALF) = w; }
            }
    }
};
struct EpiMerge {
    static constexpr bool PERM = true; const bf16* Hg; bf16* Mg;
    __device__ __forceinline__ void operator()(const Acc& acc, const Unit& u, int wr, int wc, int fr, int fq) const {
        const int br = u.tag, pn4 = u.pn - 4 * br;
        const int row0 = u.pm * BM + wr * 64 + fr, col0 = pn4 * BM + wc * 32 + 8 * fq;
#pragma unroll
        for (int ai = 0; ai < 2; ++ai)
#pragma unroll
            for (int m = 0; m < 4; ++m) {
                const int r = row0 + ai * HALF + m * 16;
#pragma unroll
                for (int bj = 0; bj < 2; ++bj) {
                    const unsigned long long* gq = (const unsigned long long*)(Hg + (size_t)r * HGW + br * 1024 + col0 + bj * HALF);
                    const unsigned long long g0 = __hip_atomic_load(gq, __ATOMIC_RELAXED, __HIP_MEMORY_SCOPE_AGENT), g1 = __hip_atomic_load(gq + 1, __ATOMIC_RELAXED, __HIP_MEMORY_SCOPE_AGENT);
                    u32x4 gt; gt.x = (unsigned)g0; gt.y = (unsigned)(g0 >> 32); gt.z = (unsigned)g1; gt.w = (unsigned)(g1 >> 32);
                    bf16* mp = Mg + (size_t)r * DM + col0 + bj * HALF;
                    const f32x4 v0 = acc[ai][bj][m][0], v1 = acc[ai][bj][m][1];
                    float o[8] = {sigmoidf_(bflo(gt.x)) * v0[0], sigmoidf_(bfhi(gt.x)) * v0[1], sigmoidf_(bflo(gt.y)) * v0[2], sigmoidf_(bfhi(gt.y)) * v0[3], sigmoidf_(bflo(gt.z)) * v1[0], sigmoidf_(bfhi(gt.z)) * v1[1], sigmoidf_(bflo(gt.w)) * v1[2], sigmoidf_(bfhi(gt.w)) * v1[3]};
                    if (br > 0) {
                        const unsigned long long q0 = __hip_atomic_load((const unsigned long long*)mp, __ATOMIC_RELAXED, __HIP_MEMORY_SCOPE_AGENT), q1 = __hip_atomic_load((const unsigned long long*)mp + 1, __ATOMIC_RELAXED, __HIP_MEMORY_SCOPE_AGENT);
                        u32x4 od; od.x = (unsigned)q0; od.y = (unsigned)(q0 >> 32); od.z = (unsigned)q1; od.w = (unsigned)(q1 >> 32); o[0] += bflo(od.x); o[1] += bfhi(od.x); o[2] += bflo(od.y); o[3] += bfhi(od.y); o[4] += bflo(od.z); o[5] += bfhi(od.z); o[6] += bflo(od.w); o[7] += bfhi(od.w); }
                    u32x4 w; w.x = pk2(o[0], o[1]); w.y = pk2(o[2], o[3]); w.z = pk2(o[4], o[5]); w.w = pk2(o[6], o[7]); *(u32x4*)mp = w;
                }
            }
    }
};
}

struct Params { const float* in[34]; float* out; unsigned char* ws; int ph_lo, ph_hi; };

struct Ctx {
    LAS unsigned char* lds; int G, bid, wv;
    float* X; unsigned char* ws;
};
#define c_W   ((bf16*)(c.ws + WS_W))
#define c_XN  ((bf16*)(c.ws + WS_XN))
#define c_HB  ((bf16*)(c.ws + WS_A))
#define c_Hm  ((bf16*)(c.ws + WS_A))
#define c_Mg  ((bf16*)(c.ws + WS_A))
#define c_P6  ((bf16*)(c.ws + WS_P6))
#define c_GQK ((bf16*)(c.ws + WS_GQK))
#define c_GV  ((bf16*)(c.ws + WS_GV))
#define c_Vt  ((bf16*)(c.ws + WS_VT))
#define c_Hg  ((bf16*)(c.ws + WS_P6))
#define c_Y   ((bf16*)(c.ws + WS_C))
#define c_BON ((float*)(c.ws + WS_BON))
#define c_GB  ((float*)(c.ws + WS_GB))
__device__ __forceinline__ const float* in_ptr(int i) {
    const char __attribute__((address_space(4)))* ka = (const char __attribute__((address_space(4)))*)__builtin_amdgcn_kernarg_segment_ptr();
    asm volatile("" : "+s"(ka));
    return *(const float* const __attribute__((address_space(4)))*)(ka + 8 * i);
}
#define PHASE_IDS() const int wave = c.wv; int lane = (int)__builtin_amdgcn_mbcnt_hi(~0u, __builtin_amdgcn_mbcnt_lo(~0u, 0u)); asm volatile("" : "+v"(lane)); const int tid = wave * 64 + lane; (void)tid

template <int MODE> __device__ __forceinline__ int wrow_map(int j) {
    if (MODE == 1) { const int up = j >= DFF, i = up ? j - DFF : j; return (i >> 7) * 256 + up * 128 + (i & 127); }
    if (MODE == 2) return j < 5384 ? j : 5632 + (j - 5384);
    return j;
}
template <int MODE> __device__ __forceinline__ void transpose_item(const float* W, int K, int N, bf16* WT, int row_off, LAS float* scr, int item, int lane) {
    const int nblk = (N + 31) / 32, kb = item / nblk, nb = item % nblk, k0 = 64 * kb, n0 = 32 * nb;
    const int colr = n0 + (lane & 31);
    float tv[32];
#pragma unroll
    for (int i = 0; i < 32; ++i) { const int kk = 2 * i + (lane >> 5); tv[i] = colr < N ? W[(size_t)(k0 + kk) * N + colr] : 0.f; }
#pragma unroll
    for (int i = 0; i < 32; ++i) { const int kk = 2 * i + (lane >> 5); scr[kk * 33 + (lane & 31)] = tv[i]; }
    asm volatile("s_waitcnt lgkmcnt(0)" ::: "memory");
    const int c = lane & 7;
#pragma unroll
    for (int j = 0; j < 4; ++j) { const int n = (lane >> 3) + 8 * j; const LAS float* s = scr + (8 * c) * 33 + n;
        u32x4 o; o.x = pk2(s[0 * 33], s[1 * 33]); o.y = pk2(s[2 * 33], s[3 * 33]); o.z = pk2(s[4 * 33], s[5 * 33]); o.w = pk2(s[6 * 33], s[7 * 33]);
        if (n0 + n < N) *(u32x4*)(WT + (size_t)(row_off + wrow_map<MODE>(n0 + n)) * K + k0 + 8 * c) = o; }
    asm volatile("s_waitcnt lgkmcnt(0)" ::: "memory");
}
__device__ __forceinline__ void ph_weights(const Ctx& c, int l) {
    PHASE_IDS();
    LAS float* scr = (LAS float*)(c.lds + wave * 16384);
    const int gw = c.bid * NWAVES + wave, NGW = c.G * NWAVES;
    constexpr int I1 = 16 * 176, I2 = 44 * 32, I3 = 16 * 265, I4 = 8 * 32, I5 = 16 * 32;
    constexpr int NIT = I1 + I2 + I3 + 3 * I4 + I5 + I1 + I2;
    const float* w1 = in_ptr(1) + (size_t)l * DM * 2 * DFF; const float* w2 = in_ptr(2) + (size_t)l * DFF * DM;
    const float* wm = in_ptr(5) + (size_t)l * DM * 8456; const float* wb = in_ptr(26) + (size_t)l * 3 * 512 * DM; const float* wo = in_ptr(27) + (size_t)l * DM * DM;
    const float* w3 = in_ptr(30) + (size_t)l * DM * 2 * DFF; const float* w4 = in_ptr(31) + (size_t)l * DFF * DM;
    for (int it = gw; it < NIT; it += NGW) {
        int r = it;
        if (r < I1) { transpose_item<1>(w1, DM, 2 * DFF, c_W + W_1, 0, scr, r, lane); continue; } r -= I1;
        if (r < I2) { transpose_item<0>(w2, DFF, DM, c_W + W_2, 0, scr, r, lane); continue; } r -= I2;
        if (r < I3) { transpose_item<2>(wm, DM, 8456, c_W + W_M, 0, scr, r, lane); continue; } r -= I3;
        if (r < 3 * I4) { const int br = r / I4; transpose_item<0>(wb + (size_t)br * 512 * DM, 512, DM, c_W + W_B, br * 1024, scr, r - br * I4, lane); continue; } r -= 3 * I4;
        if (r < I5) { transpose_item<0>(wo, DM, DM, c_W + W_O, 0, scr, r, lane); continue; } r -= I5;
        if (r < I1) { transpose_item<1>(w3, DM, 2 * DFF, c_W + W_3, 0, scr, r, lane); continue; } r -= I1;
        transpose_item<0>(w4, DFF, DM, c_W + W_4, 0, scr, r, lane);
    }
}

__device__ __forceinline__ void ph_ln(const Ctx& c, const float* g, const float* b) {
    PHASE_IDS();
    const int gw = c.bid * NWAVES + wave, NGW = c.G * NWAVES;
    f32x4 gv[4], bv[4];
#pragma unroll
    for (int j = 0; j < 4; ++j) { gv[j] = *((const f32x4*)g + lane + 64 * j); bv[j] = *((const f32x4*)b + lane + 64 * j); }
    for (int m0 = gw; m0 < MTOK; m0 += 8 * NGW) {
        f32x4 v[8][4];
#pragma unroll
        for (int r = 0; r < 8; ++r) { const int mr = (m0 + r * NGW) < MTOK ? (m0 + r * NGW) : m0; const f32x4* xr = (const f32x4*)(c.X + (size_t)mr * DM) + lane;
#pragma unroll
            for (int j = 0; j < 4; ++j) v[r][j] = xr[64 * j]; }
#pragma unroll
        for (int r = 0; r < 8; ++r) {
            const int m = m0 + r * NGW; if (m >= MTOK) break;
            f32x4* xr = (f32x4*)(c.X + (size_t)m * DM) + lane;
            float s = 0.f;
#pragma unroll
            for (int j = 0; j < 4; ++j) s += (v[r][j].x + v[r][j].y) + (v[r][j].z + v[r][j].w);
            const float mean = wave_sum(s) * (1.f / DM); float s2 = 0.f;
#pragma unroll
            for (int j = 0; j < 4; ++j) { v[r][j] = v[r][j] - mean; s2 += (v[r][j].x * v[r][j].x + v[r][j].y * v[r][j].y) + (v[r][j].z * v[r][j].z + v[r][j].w * v[r][j].w); }
            const float rstd = __builtin_amdgcn_rsqf(wave_sum(s2) * (1.f / DM) + 1e-5f);
            u32x2* o8 = (u32x2*)(c_XN + (size_t)m * DM) + lane;
#pragma unroll
            for (int j = 0; j < 4; ++j) { const f32x4 y = v[r][j] * rstd * gv[j] + bv[j]; xr[64 * j] = y; u32x2 w; w.x = pk2(y.x, y.y); w.y = pk2(y.z, y.w); o8[64 * j] = w; }
        }
    }
}
__device__ __forceinline__ void ph_x_to_bf16(const Ctx& c) {
    PHASE_IDS();
    const int gw = c.bid * NWAVES + wave, NGW = c.G * NWAVES;
    const float* xin = in_ptr(0);
    for (int m0 = gw; m0 < MTOK; m0 += 4 * NGW) {
        f32x4 y[4][4];
#pragma unroll
        for (int r = 0; r < 4; ++r) { const int mr = (m0 + r * NGW) < MTOK ? (m0 + r * NGW) : m0; const f32x4* xr = (const f32x4*)(xin + (size_t)mr * DM) + lane;
#pragma unroll
            for (int j = 0; j < 4; ++j) y[r][j] = xr[64 * j]; }
#pragma unroll
        for (int r = 0; r < 4; ++r) { const int m = m0 + r * NGW; if (m >= MTOK) break; u32x2* o8 = (u32x2*)(c_XN + (size_t)m * DM) + lane;
#pragma unroll
            for (int j = 0; j < 4; ++j) { u32x2 w; w.x = pk2(y[r][j].x, y[r][j].y); w.y = pk2(y[r][j].z, y[r][j].w); o8[64 * j] = w; } }
    }
}

__device__ __forceinline__ void ph_prep(const Ctx& c, int l) {
    LAS bf16* ACT = (LAS bf16*)c.lds;
    const float* mu = in_ptr(6) + l * 1792; const float* w0 = in_ptr(7) + l * 512; const float* wup = in_ptr(8) + l * 64 * 512;
    const float* a0 = in_ptr(9) + l * 512; const float* aup = in_ptr(10) + l * 64 * 512;
    const float* kkw = in_ptr(12) + l * 512; const float* kaw = in_ptr(13) + l * 512; const float* rkw = in_ptr(14) + l * 512;
    const float* convw = in_ptr(22) + l * 4 * 1536; const float* alog = in_ptr(23) + l * 4; const float* dtb = in_ptr(24) + l * 4;
    PHASE_IDS(); const bf16* Hm = c_Hm; const int h = wave;
    LAS bf16* RES = (LAS bf16*)(c.lds + 16384) + wave * 4096;
    const int mi = lane & 15, g4 = lane >> 4;
    bf16x8 wb[2][4][2];
#pragma unroll
    for (int mv = 0; mv < 2; ++mv)
#pragma unroll
        for (int nt = 0; nt < 4; ++nt)
#pragma unroll
            for (int ks = 0; ks < 2; ++ks) { const float* W = (mv ? aup : wup) + (size_t)(32 * ks + 8 * g4) * 512 + h * 64 + nt * 16 + mi;
                u32x4 pw; pw.x = pk2(W[0], W[512]); pw.y = pk2(W[1024], W[1536]); pw.z = pk2(W[2048], W[2560]); pw.w = pk2(W[3072], W[3584]); wb[mv][nt][ks] = __builtin_bit_cast(bf16x8, pw); }
    for (int tile = c.bid; tile < MH / 32; tile += c.G) {
        const int R0 = tile * 32, t0 = R0 & (SEQ - 1);
        __syncthreads();
#pragma unroll
        for (int e = tid; e < 32 * 128; e += 512) { const int tt = e >> 7, j = e & 127, col = 1536 + j, R = R0 + tt; const float z = bf2f(Hm[(size_t)R * HMW + col]);
            const float pv = (t0 + tt) > 0 ? bf2f(Hm[(size_t)(R - 1) * HMW + col]) : 0.f; const float s = z + mu[col] * (pv - z);
            ACT[((j < 64 ? 0 : 32) + tt) * 72 + (j & 63)] = (bf16)f2bf(j < 64 ? tanhf_(s) : s); }
        __syncthreads();
#pragma unroll
        for (int mv = 0; mv < 2; ++mv)
#pragma unroll
            for (int mt = 0; mt < 2; ++mt) {
                const bf16x8 af0 = *(const LAS bf16x8*)(ACT + (mv * 32 + mt * 16 + mi) * 72 + 8 * g4), af1 = *(const LAS bf16x8*)(ACT + (mv * 32 + mt * 16 + mi) * 72 + 32 + 8 * g4);
#pragma unroll
                for (int nt = 0; nt < 4; ++nt) {
                    f32x4 d = __builtin_amdgcn_mfma_f32_16x16x32_bf16(af0, wb[mv][nt][0], (f32x4){0.f, 0.f, 0.f, 0.f}, 0, 0, 0);
                    d = __builtin_amdgcn_mfma_f32_16x16x32_bf16(af1, wb[mv][nt][1], d, 0, 0, 0);
#pragma unroll
                    for (int i = 0; i < 4; ++i) RES[(mv * 32 + mt * 16 + 4 * g4 + i) * 64 + nt * 16 + mi] = (bf16)f2bf(d[i]);
                }
            }
        {
            const float bias = w0[tid];
#pragma unroll 1
            for (int tt = 0; tt < 32; ++tt) {
                const float acc = bias + bf2f(RES[tt * 64 + lane]);
                const float w = __expf(-0.6065306597126334f * sigmoidf_(acc));
                c_P6[((size_t)(R0 + tt) * 8 + h) * 384 + 64 + lane] = (bf16)f2bf(w);
            }
        }
        {
            const float bias = a0[tid], mur = mu[tid], muk = mu[512 + tid], muv = mu[1024 + tid], kk_ = kkw[tid], ka_ = kaw[tid], rk_ = rkw[tid];
            float pr = 0.f, pk = 0.f, pvv = 0.f;
            if (t0 > 0) { const bf16* hp = Hm + (size_t)(R0 - 1) * HMW; pr = bf2f(hp[tid]); pk = bf2f(hp[512 + tid]); pvv = bf2f(hp[1024 + tid]); }
#pragma unroll 1
            for (int tg = 0; tg < 4; ++tg) {
                bf16 zr8[8], zk8[8], zv8[8];
#pragma unroll
                for (int u = 0; u < 8; ++u) { const bf16* hp = Hm + (size_t)(R0 + tg * 8 + u) * HMW; zr8[u] = hp[tid]; zk8[u] = hp[512 + tid]; zv8[u] = hp[1024 + tid]; }
#pragma unroll
                for (int u = 0; u < 8; ++u) {
                    const int tt = tg * 8 + u;
                    const float a = sigmoidf_(bias + bf2f(RES[(32 + tt) * 64 + lane]));
                    const float zr = bf2f(zr8[u]), zk = bf2f(zk8[u]), zv = bf2f(zv8[u]);
                    const float r = zr + mur * (pr - zr), k = zk + muk * (pk - zk), v = zv + muv * (pvv - zv);
                    pr = zr; pk = zk; pvv = zv;
                    const float kx = k * kk_; const float ss = wave_sum(kx * kx); const float kk = kx * __builtin_amdgcn_rsqf(ss + 1e-6f);
                    const float kt = k * (1.0f + (a - 1.0f) * ka_);
                    const float bn = wave_sum(r * kt * rk_);
                    bf16* q = c_P6 + ((size_t)(R0 + tt) * 8 + h) * 384 + lane;
                    q[0] = (bf16)f2bf(r); q[128] = (bf16)f2bf(kt); q[192] = (bf16)f2bf(v); q[256] = (bf16)f2bf(kk); q[320] = (bf16)f2bf(kk * a);
                    if (lane == 0) c_BON[(size_t)(R0 + tt) * 8 + h] = bn;
                }
            }
        }
        for (int tk = wave; tk < 24; tk += 8) {
            const int kh = tk % 12, th = tk / 12, kind = kh >> 2, head = kh & 3, ch = kind * 512 + head * 128 + 2 * lane;
            float cw[4][2];
#pragma unroll
            for (int j = 0; j < 4; ++j) { cw[j][0] = convw[j * 1536 + ch]; cw[j][1] = convw[j * 1536 + ch + 1]; }
            const int Rs = R0 + 16 * th, ts = t0 + 16 * th;
            float x[3][2];
#pragma unroll
            for (int k = 0; k < 3; ++k) { x[k][0] = 0.f; x[k][1] = 0.f; if (ts - 3 + k >= 0) { const unsigned u = *(const unsigned*)(Hm + (size_t)(Rs - 3 + k) * HMW + C_GD + ch); x[k][0] = bflo(u); x[k][1] = bfhi(u); } }
            unsigned uu[16];
#pragma unroll
            for (int i = 0; i < 16; ++i) uu[i] = *(const unsigned*)(Hm + (size_t)(Rs + i) * HMW + C_GD + ch);
#pragma unroll
            for (int i = 0; i < 16; ++i) {
                const float z0 = bflo(uu[i]), z1 = bfhi(uu[i]);
                float y0 = cw[0][0] * x[0][0] + cw[1][0] * x[1][0] + cw[2][0] * x[2][0] + cw[3][0] * z0;
                float y1 = cw[0][1] * x[0][1] + cw[1][1] * x[1][1] + cw[2][1] * x[2][1] + cw[3][1] * z1;
                x[0][0] = x[1][0]; x[0][1] = x[1][1]; x[1][0] = x[2][0]; x[1][1] = x[2][1]; x[2][0] = z0; x[2][1] = z1;
                y0 = siluf_(y0); y1 = siluf_(y1);
                if (kind < 2) { const float ss = wave_sum(y0 * y0 + y1 * y1); float sc = __builtin_amdgcn_rsqf(ss + 1e-6f); if (kind == 0) sc *= 0.08838834764831845f; y0 *= sc; y1 *= sc;
                    *(unsigned*)(c_GQK + ((size_t)(Rs + i) * 4 + head) * 256 + kind * 128 + 2 * lane) = pk2(y0, y1); }
                else *(unsigned*)(c_GV + (size_t)(Rs + i) * 512 + head * 128 + 2 * lane) = pk2(y0, y1);
            }
        }
        if (tid < 128) { const int tt = tid >> 2, hh = tid & 3; const size_t R = R0 + tt; const float alg = bf2f(Hm[R * HMW + C_GDA + hh]), blg = bf2f(Hm[R * HMW + C_GDB + hh]);
            const float xs = alg + dtb[hh]; const float sp = xs > 20.f ? xs : log1pf(__expf(xs));
            c_GB[(R * 4 + hh) * 2] = __expf(-__expf(alog[hh]) * sp); c_GB[(R * 4 + hh) * 2 + 1] = sigmoidf_(blg); }
    }
}

__device__ __forceinline__ void rwkv_scan(const Ctx& c, int task, int lane, LAS unsigned char* wl) {
    const int rg = lane >> 4, sub = lane & 15;
    const int bh = task >> 4, row = (task & 15) * 4 + rg, bl = bh >> 3, h = bh & 7;
    const unsigned char* gsrc = (const unsigned char*)(c_P6 + ((size_t)bl * SEQ * 8 + h) * 384) + lane * 16;
    bf16* yo = c_Y + (size_t)bl * SEQ * YW + h * 64 + row;
    f32x2 sA = {0.f, 0.f}, sB = {0.f, 0.f};
    u32x4 st[16];
    const bool ld = lane < 48;
    if (ld) {
#pragma unroll
        for (int i = 0; i < 16; ++i) st[i] = *(const u32x4*)(gsrc + (size_t)i * 6144);
#pragma unroll
        for (int i = 0; i < 16; ++i) *(LAS u32x4*)(wl + lane * 16 + i * 768) = st[i];
    }
#pragma unroll 1
    for (int ch = 0; ch < SEQ / 16; ++ch) {
        const int t0 = ch * 16; const bool more = ch + 1 < SEQ / 16;
        LAS unsigned char* rb = wl + (ch & 1) * 12288;
        float yb[16];
        if (ld && more) {
#pragma unroll
            for (int i = 0; i < 16; ++i) st[i] = *(const u32x4*)(gsrc + (size_t)(t0 + 16 + i) * 6144);
        }
        u32x2 nr = *(const LAS u32x2*)(rb + sub * 8), nw = *(const LAS u32x2*)(rb + 128 + sub * 8), nk = *(const LAS u32x2*)(rb + 256 + sub * 8);
        u32x2 nkk = *(const LAS u32x2*)(rb + 512 + sub * 8), nka = *(const LAS u32x2*)(rb + 640 + sub * 8);
        bf16 nv = *(const LAS bf16*)(rb + 384 + row * 2);
        float pyv = 0.f;
#pragma unroll
        for (int i = 0; i < 16; ++i) {
            const u32x2 dr = nr, dw = nw, dk = nk, dkk = nkk, dka = nka; const float v = bf2f(nv);
            if (i + 1 < 16) { LAS unsigned char* q = rb + (i + 1) * 768;
                nr = *(const LAS u32x2*)(q + sub * 8); nw = *(const LAS u32x2*)(q + 128 + sub * 8); nk = *(const LAS u32x2*)(q + 256 + sub * 8);
                nkk = *(const LAS u32x2*)(q + 512 + sub * 8); nka = *(const LAS u32x2*)(q + 640 + sub * 8); nv = *(const LAS bf16*)(q + 384 + row * 2); }
            const f32x2 kk01 = {bflo(dkk.x), bfhi(dkk.x)}, kk23 = {bflo(dkk.y), bfhi(dkk.y)}, w01 = {bflo(dw.x), bfhi(dw.x)}, w23 = {bflo(dw.y), bfhi(dw.y)};
            const f32x2 k01 = {bflo(dk.x), bfhi(dk.x)}, k23 = {bflo(dk.y), bfhi(dk.y)}, ka01 = {bflo(dka.x), bfhi(dka.x)}, ka23 = {bflo(dka.y), bfhi(dka.y)};
            const f32x2 r01 = {bflo(dr.x), bfhi(dr.x)}, r23 = {bflo(dr.y), bfhi(dr.y)};
            const f32x2 p = sA * kk01 + sB * kk23;
            float sk = p.x + p.y, yprev = pyv;
            row_sum16x2(sk, yprev);
            if (i > 0) yb[i - 1] = yprev;
            sA = sA * w01 + (k01 * v - ka01 * sk);
            sB = sB * w23 + (k23 * v - ka23 * sk);
            const f32x2 py = sA * r01 + sB * r23;
            pyv = py.x + py.y;
        }
        yb[15] = row_sum16(pyv);
        if (sub == 0) {
#pragma unroll
            for (int i = 0; i < 16; ++i) yo[(size_t)(t0 + i) * YW] = (bf16)f2bf(yb[i]);
        }
        if (ld && more) {
            LAS unsigned char* wb = wl + ((ch + 1) & 1) * 12288 + lane * 16;
#pragma unroll
            for (int i = 0; i < 16; ++i) *(LAS u32x4*)(wb + i * 768) = st[i];
        }
    }
}
__device__ __forceinline__ void gdn_scan(const Ctx& c, int task, int lane, LAS unsigned char* wl) {
    const int rg = lane >> 4, sub = lane & 15;
    const int bh = task >> 5, cg4 = (task & 31) * 4, col = cg4 + rg, bl = bh >> 2, h = bh & 3;
    const unsigned char* gqk = (const unsigned char*)(c_GQK + ((size_t)bl * SEQ * 4 + h) * 256) + lane * 16;
    const unsigned char* gvb = lane < 16 ? (const unsigned char*)(c_GV + ((size_t)bl * SEQ + lane) * 512 + h * 128 + cg4)
                                         : (const unsigned char*)(c_GB + (((size_t)bl * SEQ + (lane - 16)) * 4 + h) * 2);
    const size_t vstep = lane < 16 ? 1024 : 32;
    bf16* yo = c_Y + (size_t)bl * SEQ * YW + 1024 + h * 128 + col;
    f32x2 g0 = {0.f, 0.f}, g1 = {0.f, 0.f}, g2 = {0.f, 0.f}, g3 = {0.f, 0.f};
    u32x4 st[16]; u32x2 sv;
    const bool ld = lane < 32;
    constexpr int BUF = 8192 + 256;
    if (ld) {
#pragma unroll
        for (int i = 0; i < 16; ++i) st[i] = *(const u32x4*)(gqk + (size_t)i * 2048);
        sv = *(const u32x2*)gvb;
#pragma unroll
        for (int i = 0; i < 16; ++i) *(LAS u32x4*)(wl + lane * 16 + i * 512) = st[i];
        *(LAS u32x2*)(wl + 8192 + lane * 8) = sv;
    }
#pragma unroll 1
    for (int ch = 0; ch < SEQ / 16; ++ch) {
        const int t0 = ch * 16; const bool more = ch + 1 < SEQ / 16;
        LAS unsigned char* rb = wl + (ch & 1) * BUF;
        float yb[16];
        if (ld && more) {
#pragma unroll
            for (int i = 0; i < 16; ++i) st[i] = *(const u32x4*)(gqk + (size_t)(t0 + 16 + i) * 2048);
            sv = *(const u32x2*)(gvb + (size_t)(t0 + 16) * vstep);
        }
        u32x4 nq = *(const LAS u32x4*)(rb + sub * 16), nk = *(const LAS u32x4*)(rb + 256 + sub * 16);
        bf16 nv = *(const LAS bf16*)(rb + 8192 + rg * 2); f32x2 ngb = *(const LAS f32x2*)(rb + 8192 + 128);
        float pov = 0.f;
#pragma unroll
        for (int i = 0; i < 16; ++i) {
            const u32x4 dq = nq, dk = nk; const float v = bf2f(nv); const f32x2 gb = ngb;
            if (i + 1 < 16) { nq = *(const LAS u32x4*)(rb + (i + 1) * 512 + sub * 16); nk = *(const LAS u32x4*)(rb + (i + 1) * 512 + 256 + sub * 16);
                nv = *(const LAS bf16*)(rb + 8192 + (i + 1) * 8 + rg * 2); ngb = *(const LAS f32x2*)(rb + 8192 + 128 + (i + 1) * 8); }
            const f32x2 k01 = {bflo(dk.x), bfhi(dk.x)}, k23 = {bflo(dk.y), bfhi(dk.y)}, k45 = {bflo(dk.z), bfhi(dk.z)}, k67 = {bflo(dk.w), bfhi(dk.w)};
            const f32x2 q01 = {bflo(dq.x), bfhi(dq.x)}, q23 = {bflo(dq.y), bfhi(dq.y)}, q45 = {bflo(dq.z), bfhi(dq.z)}, q67 = {bflo(dq.w), bfhi(dq.w)};
            const float eg = gb.x, beta = gb.y;
            const f32x2 p = (g0 * k01 + g1 * k23) + (g2 * k45 + g3 * k67);
            float ks = p.x + p.y, oprev = pov;
            row_sum16x2(ks, oprev);
            if (i > 0) yb[i - 1] = oprev;
            const float u = beta * (v - eg * ks);
            g0 = g0 * eg + k01 * u; g1 = g1 * eg + k23 * u; g2 = g2 * eg + k45 * u; g3 = g3 * eg + k67 * u;
            const f32x2 po = (g0 * q01 + g1 * q23) + (g2 * q45 + g3 * q67);
            pov = po.x + po.y;
        }
        yb[15] = row_sum16(pov);
        if (sub == 0) {
#pragma unroll
            for (int i = 0; i < 16; ++i) yo[(size_t)(t0 + i) * YW] = (bf16)f2bf(yb[i]);
        }
        if (ld && more) {
            LAS unsigned char* wb = wl + ((ch + 1) & 1) * BUF;
#pragma unroll
            for (int i = 0; i < 16; ++i) *(LAS u32x4*)(wb + lane * 16 + i * 512) = st[i];
            *(LAS u32x2*)(wb + 8192 + lane * 8) = sv;
        }
    }
}
__device__ __forceinline__ void attn_tile(const Ctx& c, int lane, int bh, int qt, float lam, float lam_init, const float* ng) {
    const int qi = lane & 15, g = lane >> 4;
    const int bl = bh >> 2, h = bh & 3, q0 = qt * 16;
    const bf16* Hb = c_Hm + (size_t)bl * SEQ * HMW;
    bf16x8 qf[2][2];
#pragma unroll
    for (int m = 0; m < 2; ++m)
#pragma unroll
        for (int s = 0; s < 2; ++s) qf[m][s] = *(const bf16x8*)(Hb + (size_t)(q0 + qi) * HMW + C_DA + h * 128 + m * 64 + s * 32 + g * 8);
    const bf16* Kb = Hb + C_DAK + h * 128 + g * 8;
    const bf16* Vb = c_Vt + ((size_t)(bl * 4 + h) * 128 + qi) * SEQ + 8 * g;
    const int krow = 8 * (qi >> 2) + (qi & 3);
    f32x4 O[2][8];
#pragma unroll
    for (int m = 0; m < 2; ++m)
#pragma unroll
        for (int d = 0; d < 8; ++d) O[m][d] = (f32x4){0.f, 0.f, 0.f, 0.f};
    float Mx[2] = {-1e30f, -1e30f}, L[2] = {0.f, 0.f};
    const float c1 = 0.125f * 1.4426950408889634f;
    const float c2 = exp2f(-2.0f * (float)(h + 1)) * 1.4426950408889634f;
    const int nb = qt / 2 + 1;
    for (int blk = nb - 1; blk >= 0; --blk) {
        const int kb = blk * 32;
        bf16x8 kf[2][2][2], vf[8];
#pragma unroll
        for (int m = 0; m < 2; ++m)
#pragma unroll
            for (int ta = 0; ta < 2; ++ta)
#pragma unroll
                for (int s = 0; s < 2; ++s) kf[m][ta][s] = *(const bf16x8*)(Kb + (size_t)(kb + krow + 4 * ta) * HMW + m * 64 + s * 32);
#pragma unroll
        for (int d = 0; d < 8; ++d) vf[d] = *(const bf16x8*)(Vb + (size_t)d * 16 * SEQ + kb);
        const int base = kb + 8 * g - (q0 + qi);
        const float fb = c2 * (float)base;
        bf16x8 pf[2];
#pragma unroll
        for (int m = 0; m < 2; ++m) {
            f32x4 S[2];
#pragma unroll
            for (int ta = 0; ta < 2; ++ta) { S[ta] = __builtin_amdgcn_mfma_f32_16x16x32_bf16(kf[m][ta][0], qf[m][0], (f32x4){0.f, 0.f, 0.f, 0.f}, 0, 0, 0); S[ta] = __builtin_amdgcn_mfma_f32_16x16x32_bf16(kf[m][ta][1], qf[m][1], S[ta], 0, 0, 0); }
            float x[8]; float mx = -1e30f;
#pragma unroll
            for (int ta = 0; ta < 2; ++ta)
#pragma unroll
                for (int i = 0; i < 4; ++i) { const int dd = base + 4 * ta + i; float v = S[ta][i] * c1 + (fb + c2 * (float)(4 * ta + i)); v = dd > 0 ? -1e30f : v; x[ta * 4 + i] = v; mx = fmaxf(mx, v); }
            mx = fmaxf(mx, __shfl_xor(mx, 16)); mx = fmaxf(mx, __shfl_xor(mx, 32));
            const float mn = fmaxf(Mx[m], mx), al = __builtin_amdgcn_exp2f(Mx[m] - mn);
            float rs = 0.f;
#pragma unroll
            for (int j = 0; j < 8; ++j) { x[j] = __builtin_amdgcn_exp2f(x[j] - mn); rs += x[j]; }
            if (__builtin_amdgcn_ballot_w64(mn != Mx[m]) != 0ull) {
                L[m] = L[m] * al; Mx[m] = mn;
#pragma unroll
                for (int d = 0; d < 8; ++d) O[m][d] = O[m][d] * al;
            }
            L[m] += rs;
            u32x4 pw; pw.x = pk2(x[0], x[1]); pw.y = pk2(x[2], x[3]); pw.z = pk2(x[4], x[5]); pw.w = pk2(x[6], x[7]);
            pf[m] = __builtin_bit_cast(bf16x8, pw);
        }
#pragma unroll
        for (int d = 0; d < 8; ++d) { O[0][d] = __builtin_amdgcn_mfma_f32_16x16x32_bf16(vf[d], pf[0], O[0][d], 0, 0, 0); O[1][d] = __builtin_amdgcn_mfma_f32_16x16x32_bf16(vf[d], pf[1], O[1][d], 0, 0, 0); }
    }
    float l0 = L[0]; l0 += __shfl_xor(l0, 16); l0 += __shfl_xor(l0, 32);
    float l1 = L[1]; l1 += __shfl_xor(l1, 16); l1 += __shfl_xor(l1, 32);
    const float i0 = 1.0f / l0, i1 = lam / l1;
    float ss = 0.f;
#pragma unroll
    for (int d = 0; d < 8; ++d) { O[0][d] = O[0][d] * i0 - O[1][d] * i1; ss += (O[0][d][0] * O[0][d][0] + O[0][d][1] * O[0][d][1]) + (O[0][d][2] * O[0][d][2] + O[0][d][3] * O[0][d][3]); }
    ss += __shfl_xor(ss, 16); ss += __shfl_xor(ss, 32);
    const float sc = __builtin_amdgcn_rsqf(ss * (1.0f / 128.0f) + 1e-5f) * (1.0f - lam_init);
    bf16* yo = c_Y + (size_t)(bl * SEQ + q0 + qi) * YW + 512 + h * 128 + 4 * g;
#pragma unroll
    for (int d = 0; d < 8; ++d) { const f32x4 gg = *(const f32x4*)(ng + 16 * d + 4 * g); const f32x4 o = O[0][d] * sc * gg; u32x2 w; w.x = pk2(o[0], o[1]); w.y = pk2(o[2], o[3]); *(u32x2*)(yo + 16 * d) = w; }
}
__device__ __forceinline__ void ph_mix(const Ctx& c, int l, int roles) {
    PHASE_IDS();
    if (wave < 2) {
        if (!(roles & 1)) return;
#if !SKIP_RW
        __builtin_amdgcn_s_setprio(3);
        for (int task = c.bid * 2 + wave; task < 512; task += c.G * 2) rwkv_scan(c, task, lane, c.lds + wave * 24576);
        __builtin_amdgcn_s_setprio(0);
#endif
    } else if (wave < 4) {
        if (!(roles & 2)) return;
#if !SKIP_GD
        __builtin_amdgcn_s_setprio(3);
        for (int task = c.bid * 2 + (wave - 2); task < 512; task += c.G * 2) gdn_scan(c, task, lane, c.lds + wave * 24576);
        __builtin_amdgcn_s_setprio(0);
#endif
    } else {
        if (!(roles & 4)) return;
#if !SKIP_DA
        const float lam_init = 0.8f - 0.6f * __expf(-0.3f * (float)l);
        const float d1 = wave_sum(in_ptr(17)[l * 64 + lane] * in_ptr(18)[l * 64 + lane]), d2 = wave_sum(in_ptr(19)[l * 64 + lane] * in_ptr(20)[l * 64 + lane]);
        const float lam = __expf(d1) - __expf(d2) + lam_init;
        const float* ng = in_ptr(21) + l * 128;
        if (wave >= 6) return;
        for (int p = c.bid * 2 + (wave - 4); p < 2048; p += c.G * 2) { const int bh = p >> 7, j = p & 127; attn_tile(c, lane, bh, 255 - j, lam, lam_init, ng); attn_tile(c, lane, bh, j, lam, lam_init, ng); }
#endif
    }
}

__device__ __forceinline__ void ph_post(const Ctx& c, int l) {
    LAS bf16* ACT = (LAS bf16*)c.lds;
    const float* mu = in_ptr(6) + l * 1792; const float* gup = in_ptr(11) + l * 128 * 512;
    const float* lng = in_ptr(15) + l * 512; const float* lnb = in_ptr(16) + l * 512; const float* gng = in_ptr(25) + l * 128;
    PHASE_IDS(); const bf16* Hm = c_Hm; const int h = wave;
    LAS bf16* RES = (LAS bf16*)(c.lds + 16384) + wave * 2048;
    const int mi = lane & 15, g4 = lane >> 4;
    bf16x8 wb[4][4];
#pragma unroll
    for (int nt = 0; nt < 4; ++nt)
#pragma unroll
        for (int ks = 0; ks < 4; ++ks) { const float* W = gup + (size_t)(32 * ks + 8 * g4) * 512 + h * 64 + nt * 16 + mi;
            u32x4 pw; pw.x = pk2(W[0], W[512]); pw.y = pk2(W[1024], W[1536]); pw.z = pk2(W[2048], W[2560]); pw.w = pk2(W[3072], W[3584]); wb[nt][ks] = __builtin_bit_cast(bf16x8, pw); }
    for (int tile = c.bid; tile < MH / 32; tile += c.G) {
        const int R0 = tile * 32, t0 = R0 & (SEQ - 1);
        __syncthreads();
#pragma unroll
        for (int e = tid; e < 32 * 128; e += 512) { const int tt = e >> 7, j = e & 127, col = 1664 + j, R = R0 + tt; const float z = bf2f(Hm[(size_t)R * HMW + col]);
            const float pv = (t0 + tt) > 0 ? bf2f(Hm[(size_t)(R - 1) * HMW + col]) : 0.f; ACT[tt * 136 + j] = (bf16)f2bf(sigmoidf_(z + mu[col] * (pv - z))); }
        __syncthreads();
#pragma unroll
        for (int mt = 0; mt < 2; ++mt) {
            bf16x8 af[4];
#pragma unroll
            for (int ks = 0; ks < 4; ++ks) af[ks] = *(const LAS bf16x8*)(ACT + (mt * 16 + mi) * 136 + 32 * ks + 8 * g4);
#pragma unroll
            for (int nt = 0; nt < 4; ++nt) {
                f32x4 d = (f32x4){0.f, 0.f, 0.f, 0.f};
#pragma unroll
                for (int ks = 0; ks < 4; ++ks) d = __builtin_amdgcn_mfma_f32_16x16x32_bf16(af[ks], wb[nt][ks], d, 0, 0, 0);
#pragma unroll
                for (int i = 0; i < 4; ++i) RES[(mt * 16 + 4 * g4 + i) * 64 + nt * 16 + mi] = (bf16)f2bf(d[i]);
            }
        }
        {
            const float muv = mu[1024 + tid], lg = lng[tid], lb = lnb[tid];
            float pvv = 0.f; if (t0 > 0) pvv = bf2f(Hm[(size_t)(R0 - 1) * HMW + 1024 + tid]);
#pragma unroll 1
            for (int tg = 0; tg < 4; ++tg) {
                bf16 y8[8], zv8[8]; float bn8[8];
#pragma unroll
                for (int u = 0; u < 8; ++u) { const size_t R = R0 + tg * 8 + u; y8[u] = c_Y[R * YW + tid]; zv8[u] = Hm[R * HMW + 1024 + tid]; bn8[u] = c_BON[R * 8 + h]; }
#pragma unroll
                for (int u = 0; u < 8; ++u) {
                    const int tt = tg * 8 + u;
                    const float acc = bf2f(RES[tt * 64 + lane]);
                    const size_t R = R0 + tt;
                    const float y = bf2f(y8[u]);
                    const float mean = wave_sum(y) * (1.0f / 64.0f), d = y - mean, var = wave_sum(d * d) * (1.0f / 64.0f);
                    const float yn = d * __builtin_amdgcn_rsqf(var + 64e-5f) * lg + lb;
                    const float zv = bf2f(zv8[u]); const float v = zv + muv * (pvv - zv); pvv = zv;
                    float o = (yn + bn8[u] * v) * acc;
#if SKIP_RW
                    o = 0.f;
#endif
                    c_Y[R * YW + tid] = (bf16)f2bf(o);
                }
            }
        }
        {
            unsigned yu[4][4], zz[4][4];
#pragma unroll
            for (int a = 0; a < 4; ++a)
#pragma unroll
                for (int hh = 0; hh < 4; ++hh) { const size_t R = R0 + wave + 8 * a; yu[a][hh] = *(const unsigned*)(c_Y + R * YW + 1024 + hh * 128 + 2 * lane); zz[a][hh] = *(const unsigned*)(Hm + R * HMW + C_GDZ + hh * 128 + 2 * lane); }
            const float gn0 = gng[2 * lane], gn1 = gng[2 * lane + 1];
#pragma unroll
            for (int a = 0; a < 4; ++a) {
                const size_t R = R0 + wave + 8 * a;
#pragma unroll
                for (int hh = 0; hh < 4; ++hh) {
                    const float o0 = bflo(yu[a][hh]), o1 = bfhi(yu[a][hh]);
                    const float ss = wave_sum(o0 * o0 + o1 * o1) * (1.0f / 128.0f), sc = __builtin_amdgcn_rsqf(ss + 1e-6f);
                    float r0 = o0 * sc * gn0 * siluf_(bflo(zz[a][hh])), r1 = o1 * sc * gn1 * siluf_(bfhi(zz[a][hh]));
#if SKIP_GD
                    r0 = 0.f; r1 = 0.f;
#endif
                    *(unsigned*)(c_Y + R * YW + 1024 + hh * 128 + 2 * lane) = pk2(r0, r1);
                }
#if SKIP_DA
                for (int e = lane; e < 256; e += 64) *(unsigned*)(c_Y + R * YW + 512 + 2 * e) = 0u;
#endif
            }
        }
    }
}

constexpr int PH_PER_LAYER = 20;
__global__ void __launch_bounds__(NWAVES * 64, 2) fwd_kernel(Params p) {
    extern __shared__ __attribute__((aligned(16))) unsigned char lds_raw[];
    cg::grid_group grid = cg::this_grid();
    if (p.ph_hi < 0) grid.sync();
    Ctx c;
    c.lds = (LAS unsigned char*)lds_raw; c.wv = __builtin_amdgcn_readfirstlane(threadIdx.x >> 6); c.G = gridDim.x; c.bid = blockIdx.x;
    c.X = p.out; c.ws = p.ws;
    volatile LAS unsigned* bst = (volatile LAS unsigned*)(c.lds + 131072 + 512);
    { const int t_ = threadIdx.x; if (t_ < 2) bst[t_] = 0u; }
    __syncthreads();
    const XcdBarrier bar = xcd_barrier_post((unsigned*)(p.ws + WS_BAR), bst);
    for (int ph = p.ph_lo; ph < p.ph_hi; ++ph) {
        const int l = ph / PH_PER_LAYER, k = ph % PH_PER_LAYER;
        pg8::TileOrder S;
#ifndef PHMASK
#define PHMASK 255
#endif
        if (k == 0 && l > 0) continue;
        const int wl = (l == 0 && (k == 0 || k == 19)) ? (k == 0 ? 0 : 1) : -1;
        if (k == 0) ph_x_to_bf16(c);
        else if (k == 1 || k == 17) {
            pg8::Gemm g{c_XN, c_W + (k == 1 ? W_1 : W_3), DM, DM}; S.init(MTOK, 2 * DFF, c.G, c.bid, 1);
            pg8::EpiSwiglu E{c_HB}; pg8::gemm_phase(c.lds, g, S, E, c.wv);
        } else if (k == 2 || k == 18) {
            pg8::Gemm g{c_HB, c_W + (k == 2 ? W_2 : W_4), DFF, DFF}; S.init(MTOK, DM, c.G, c.bid, 1);
            pg8::EpiResid E{(l == 0 && k == 2) ? in_ptr(0) : c.X, c.X, ALPHA, 0.5f}; pg8::gemm_phase(c.lds, g, S, E, c.wv);
        } else if (k == 3) ph_ln(c, in_ptr(3) + l * DM, in_ptr(4) + l * DM);
        else if (k == 16) ph_ln(c, in_ptr(28) + l * DM, in_ptr(29) + l * DM);
        else if (k == 19) ph_ln(c, in_ptr(32) + l * DM, in_ptr(33) + l * DM);
        else {
            const int hb = (k - 4) / 6, kk = (k - 4) % 6;
            const bf16* XNh = c_XN + (size_t)hb * MH * DM; float* Xh = c.X + (size_t)hb * MH * DM;
#if SKIP_MIX
            if (kk == 5) { pg8::Gemm g{XNh, c_W + W_O, DM, DM}; S.init(MH, DM, c.G, c.bid, 1); pg8::EpiResid E{Xh, Xh, ALPHA, 0.0f}; pg8::gemm_phase(c.lds, g, S, E, c.wv); }
#else
            if (kk == 0) { pg8::Gemm g{XNh, c_W + W_M, DM, DM}; S.init(MH, HMW, c.G, c.bid, 1); S.sw = 1; pg8::EpiHm E{c_Hm, c_Vt, HMW, 11}; pg8::gemm_phase(c.lds, g, S, E, c.wv); }
            else if (kk == 1) { if (PHMASK & 2) { ph_prep(c, l);
#ifdef REPEAT_PREP
                ph_prep(c, l);
#endif
            } }
            else if (kk == 2) { if (PHMASK & 4) { ph_mix(c, l, 7);
#ifdef REPEAT_MIX
                ph_mix(c, l, REPEAT_MIX);
#endif
            } }
            else if (kk == 3) { if (PHMASK & 8) ph_post(c, l);
                __syncthreads();
                pg8::Gemm g{XNh, c_W + W_G, DM, DM}; S.init(MH, HGW, c.G, c.bid, 1); pg8::EpiHm E{c_Hg, c_Vt, HGW, 1 << 20}; pg8::gemm_phase(c.lds, g, S, E, c.wv); }
            else if (kk == 4) { pg8::Gemm g{c_Y, c_W + W_B, YW, 512}; S.init(MH, DM, c.G, c.bid, 3); pg8::EpiMerge E{c_Hg, c_Mg}; pg8::gemm_phase(c.lds, g, S, E, c.wv); }
            else { pg8::Gemm g{c_Mg, c_W + W_O, DM, DM}; S.init(MH, DM, c.G, c.bid, 1); pg8::EpiResid E{Xh, Xh, ALPHA, 1.0f}; pg8::gemm_phase<pg8::EpiResid, 16>(c.lds, g, S, E, c.wv); }
#endif
        }
        if (wl >= 0) ph_weights(c, wl);
        if (ph + 1 < p.ph_hi || DBG_DUMP) {
#if USE_CG_SYNC
            __builtin_amdgcn_fence(__ATOMIC_RELEASE, "agent"); asm volatile("s_waitcnt vmcnt(0) lgkmcnt(0)" ::: "memory");
            grid.sync();
            __builtin_amdgcn_fence(__ATOMIC_ACQUIRE, "agent"); asm volatile("s_waitcnt vmcnt(0)" ::: "memory");
#else
            xcd_barrier(bar, c.wv);
#endif
        }
    }
#if DBG_DUMP
    {
        const bf16* src = (const bf16*)(p.ws + DBG_SRC);
        const size_t n = (size_t)DBG_N, tot = (size_t)MTOK * DM;
        for (size_t i = (size_t)blockIdx.x * 512 + threadIdx.x; i < tot; i += (size_t)gridDim.x * 512) p.out[i] = i < n ? bf2f(src[i]) : 0.f;
    }
#endif
}

extern "C" void kernel_launch(void* const* d_in, const int* in_sizes, int n_in, void* d_out, int out_size, void* d_ws, size_t ws_size, hipStream_t stream) {
    static int grid = 0;
    if (grid == 0) {
        if (n_in != 34 || out_size != MTOK * DM || ws_size < WS_END) { fprintf(stderr, "kernel_launch: unexpected problem (n_in %d out %d ws %zu)\n", n_in, out_size, ws_size); grid = -1; return; }
        int dev = 0, cus = 0, per_cu = 0;
        hipGetDevice(&dev); hipDeviceGetAttribute(&cus, hipDeviceAttributeMultiprocessorCount, dev);
        hipFuncSetAttribute((const void*)fwd_kernel, hipFuncAttributeMaxDynamicSharedMemorySize, LDS_BYTES);
        hipOccupancyMaxActiveBlocksPerMultiprocessor(&per_cu, (const void*)fwd_kernel, NWAVES * 64, LDS_BYTES);
        if (per_cu < 1) per_cu = 1;
        grid = cus * per_cu; if (grid > 256) grid = 256;
        (void)hipGetLastError();
    }
    if (grid < 0) return;
    if (hipMemsetAsync((char*)d_ws + WS_BAR, 0, XCD_BAR_WORDS * 4, stream) != hipSuccess) { fprintf(stderr, "memset failed\n"); return; }
    Params p{};
    for (int i = 0; i < 34; ++i) p.in[i] = (const float*)d_in[i];
    p.out = (float*)d_out; p.ws = (unsigned char*)d_ws; p.ph_lo = 0; p.ph_hi = DBG_HI;
    void* args[] = {&p};
    hipError_t e = hipLaunchCooperativeKernel((const void*)fwd_kernel, dim3(grid), dim3(NWAVES * 64), args, LDS_BYTES, stream);
    if (e != hipSuccess) fprintf(stderr, "cooperative launch failed: %s (grid %d)\n", hipGetErrorString(e), grid);
}
```
